# Optimizing an MI355X kernel written in HIP

```python
import math
import jax, jax.numpy as jnp
from jax import lax
import numpy as np

D_MODEL = 2048
BATCH = 4
SEQ = 4096
DEPTH = 4

CHUNK = 64
Q_BLOCK = 128
ROPE_THETA = 500000.0
NORM_EPS = 1e-6
NEG_INF = -1e30
PLE_DIM = 256
HEAD_DIM = 128

A_HEADS = 6
A_Q_RANK = 384
A_KV_RANK = 256
A_NOPE = 128
A_ROPE = 64
A_V = 128
A_WIDTH = A_HEADS * A_V
B_HEADS = 5
B_WIDTH = B_HEADS * HEAD_DIM
IDX_HEADS = 8
IDX_DIM = 64
TOPK_MAX = 256
C_HEADS = 5
C_QK = 64
C_V = 128
C_WIDTH = C_HEADS * C_V
D_MIX = A_WIDTH + B_WIDTH + C_WIDTH

IN_SPLITS = (A_Q_RANK, A_KV_RANK, A_ROPE, A_WIDTH,
             B_WIDTH, B_WIDTH, B_WIDTH, IDX_HEADS * IDX_DIM, IDX_DIM, IDX_HEADS, B_WIDTH,
             C_HEADS * 2 * C_QK, C_HEADS * 2 * C_QK, C_WIDTH, C_WIDTH)
D_IN = sum(IN_SPLITS)

kernel_name = "hybrid_mla_dsa_diff_streaming_block"


def rms_norm(x, g):
    xf = x.astype(jnp.float32)
    y = xf * lax.rsqrt(jnp.mean(xf * xf, axis=-1, keepdims=True) + NORM_EPS)
    return (y * g.astype(jnp.float32)).astype(x.dtype)


def rope(x, pos, n_rot):
    half = n_rot // 2
    inv_freq = 1.0 / (ROPE_THETA ** (jnp.arange(half, dtype=jnp.float32) * (2.0 / n_rot)))
    ang = pos.astype(jnp.float32)[:, :, None] * inv_freq
    cos = jnp.cos(ang)[:, :, None, :]
    sin = jnp.sin(ang)[:, :, None, :]
    x1 = x[..., :half].astype(jnp.float32)
    x2 = x[..., half:n_rot].astype(jnp.float32)
    rot = jnp.concatenate([x1 * cos - x2 * sin, x2 * cos + x1 * sin], axis=-1).astype(x.dtype)
    return jnp.concatenate([rot, x[..., n_rot:]], axis=-1)


def split_cols(z, sizes):
    out, o = [], 0
    for sz in sizes:
        out.append(z[..., o:o + sz])
        o += sz
    return out


def to_blocks(a):
    b, s = a.shape[:2]
    return jnp.swapaxes(a.reshape(b, s // Q_BLOCK, Q_BLOCK, *a.shape[2:]), 0, 1)


def from_blocks(a):
    nb, b, qb = a.shape[:3]
    return jnp.swapaxes(a, 0, 1).reshape(b, nb * qb, *a.shape[3:])


def chunk_mask(blk, seq):
    q_pos = blk * Q_BLOCK + jnp.arange(Q_BLOCK)
    k_pos = jnp.arange(seq)
    return (k_pos // CHUNK)[None, :] <= (q_pos // CHUNK)[:, None]


def masked_softmax(scores, mask):
    return jax.nn.softmax(jnp.where(mask, scores.astype(jnp.float32), NEG_INF), axis=-1)


def mla_mixer(c_q, c_kv, k_rope, pos, q_norm_g, kv_norm_g, w_uq, w_ukv):
    b, s, _ = c_q.shape
    q = (rms_norm(c_q, q_norm_g) @ w_uq).reshape(b, s, A_HEADS, A_NOPE + A_ROPE)
    q = jnp.concatenate([q[..., :A_NOPE], rope(q[..., A_NOPE:], pos, A_ROPE)], axis=-1)
    kv = (rms_norm(c_kv, kv_norm_g) @ w_ukv).reshape(b, s, A_HEADS, A_NOPE + A_V)
    k_pe = rope(k_rope[:, :, None, :], pos, A_ROPE)
    k = jnp.concatenate([kv[..., :A_NOPE], jnp.broadcast_to(k_pe, (b, s, A_HEADS, A_ROPE))], axis=-1)
    v = kv[..., A_NOPE:]
    scale = (A_NOPE + A_ROPE) ** -0.5

    def block(args):
        blk, qb = args
        sc = jnp.einsum('bqhd,bkhd->bhqk', qb, k) * scale
        pr = masked_softmax(sc, chunk_mask(blk, s)).astype(v.dtype)
        return jnp.einsum('bhqk,bkhd->bqhd', pr, v)

    o = from_blocks(lax.map(block, (jnp.arange(s // Q_BLOCK), to_blocks(q))))
    return o.reshape(b, s, A_WIDTH)


def dsa_mixer(q, k, v, q_idx, k_idx, w_idx, pos):
    b, s, _ = q.shape
    q = rope(q.reshape(b, s, B_HEADS, HEAD_DIM), pos, HEAD_DIM // 4)
    k = rope(k.reshape(b, s, B_HEADS, HEAD_DIM), pos, HEAD_DIM // 4)
    v = v.reshape(b, s, B_HEADS, HEAD_DIM)
    qi = rope(q_idx.reshape(b, s, IDX_HEADS, IDX_DIM), pos, IDX_DIM // 4)
    ki = rope(k_idx[:, :, None, :], pos, IDX_DIM // 4)[:, :, 0, :]
    n_sel = min(TOPK_MAX, s // 4)
    scale = HEAD_DIM ** -0.5

    def block(args):
        blk, qb, qib, wb = args
        mask = chunk_mask(blk, s)
        rel = jax.nn.relu(jnp.einsum('bqhd,bkd->bqhk', qib, ki).astype(jnp.float32))
        score = jnp.einsum('bqhk,bqh->bqk', rel, wb.astype(jnp.float32))
        score = jnp.where(mask[None], score, NEG_INF)
        top_val, top_idx = lax.top_k(score, n_sel)
        valid = top_val > 0.5 * NEG_INF
        kg = jax.vmap(lambda kk, ii: kk[ii])(k, top_idx)
        vg = jax.vmap(lambda vv, ii: vv[ii])(v, top_idx)
        sc = jnp.einsum('bqhd,bqkhd->bhqk', qb, kg) * scale
        pr = masked_softmax(sc, valid[:, None]).astype(v.dtype)
        return jnp.einsum('bhqk,bqkhd->bqhd', pr, vg)

    o = from_blocks(lax.map(block, (jnp.arange(s // Q_BLOCK), to_blocks(q), to_blocks(qi), to_blocks(w_idx))))
    return o.reshape(b, s, B_WIDTH)


def diff_mixer(q, k, v, pos, lam, lam_init, subln_g):
    b, s, _ = q.shape
    q = rope(q.reshape(b, s, C_HEADS * 2, C_QK), pos, C_QK // 4).reshape(b, s, C_HEADS, 2, C_QK)
    k = rope(k.reshape(b, s, C_HEADS * 2, C_QK), pos, C_QK // 4).reshape(b, s, C_HEADS, 2, C_QK)
    v = v.reshape(b, s, C_HEADS, C_V)
    k1, k2 = k[..., 0, :], k[..., 1, :]
    scale = C_QK ** -0.5

    def block(args):
        blk, qb = args
        mask = chunk_mask(blk, s)
        a1 = masked_softmax(jnp.einsum('bqhd,bkhd->bhqk', qb[..., 0, :], k1) * scale, mask)
        a2 = masked_softmax(jnp.einsum('bqhd,bkhd->bhqk', qb[..., 1, :], k2) * scale, mask)
        pr = (a1 - lam * a2).astype(v.dtype)
        return jnp.einsum('bhqk,bkhd->bqhd', pr, v)

    o = from_blocks(lax.map(block, (jnp.arange(s // Q_BLOCK), to_blocks(q))))
    o = rms_norm(o, subln_g) * (1.0 - lam_init)
    return o.reshape(b, s, C_WIDTH)


def setup_inputs(seed: int = 0) -> dict:
    key = jax.random.key(seed)
    ks = jax.random.split(key, 20)
    f32 = jnp.float32
    nrm = lambda k, shape, sc: jax.random.normal(k, shape, f32) * sc
    x = nrm(ks[0], (BATCH, SEQ, D_MODEL), 1.0)
    p = nrm(ks[1], (DEPTH, BATCH, SEQ, PLE_DIM), 1.0)
    start = jax.random.randint(ks[2], (BATCH, 1), 0, 64, dtype=jnp.int32) * CHUNK
    positions = (start + jnp.arange(SEQ, dtype=jnp.int32)[None, :]).astype(jnp.int32)
    return {
        "x": x,
        "p": p,
        "positions": positions,
        "w_in": nrm(ks[3], (DEPTH, D_MODEL, D_IN), D_MODEL ** -0.5),
        "w_uq": nrm(ks[4], (DEPTH, A_Q_RANK, A_HEADS * (A_NOPE + A_ROPE)), A_Q_RANK ** -0.5),
        "w_ukv": nrm(ks[5], (DEPTH, A_KV_RANK, A_HEADS * (A_NOPE + A_V)), A_KV_RANK ** -0.5),
        "w_o": nrm(ks[6], (DEPTH, D_MIX, D_MODEL), D_MIX ** -0.5),
        "norm_g": 1.0 + nrm(ks[7], (DEPTH, D_MODEL), 0.02),
        "q_norm_g": 1.0 + nrm(ks[8], (DEPTH, A_Q_RANK), 0.02),
        "kv_norm_g": 1.0 + nrm(ks[9], (DEPTH, A_KV_RANK), 0.02),
        "lam_q1": nrm(ks[10], (DEPTH, C_QK), 0.1),
        "lam_k1": nrm(ks[11], (DEPTH, C_QK), 0.1),
        "lam_q2": nrm(ks[12], (DEPTH, C_QK), 0.1),
        "lam_k2": nrm(ks[13], (DEPTH, C_QK), 0.1),
        "subln_g": 1.0 + nrm(ks[14], (DEPTH, C_V), 0.02),
        "w_ple": nrm(ks[15], (DEPTH, PLE_DIM, D_MODEL), PLE_DIM ** -0.5),
        "w_pg": nrm(ks[16], (DEPTH, D_MODEL, D_MODEL), D_MODEL ** -0.5),
        "final_g": 1.0 + nrm(ks[17], (D_MODEL,), 0.02),
    }


def reference(x, p, positions, w_in, w_uq, w_ukv, w_o, norm_g, q_norm_g, kv_norm_g,
              lam_q1, lam_k1, lam_q2, lam_k2, subln_g, w_ple, w_pg, final_g):
    h = x
    f32 = jnp.float32
    for i in range(DEPTH):
        u = rms_norm(h, norm_g[i])
        z = u @ w_in[i]
        (c_q, c_kv, k_rope, g_a,
         q_b, k_b, v_b, q_idx, k_idx, w_idx, g_b,
         q_c, k_c, v_c, g_c) = split_cols(z, IN_SPLITS)
        o_a = mla_mixer(c_q, c_kv, k_rope, positions, q_norm_g[i], kv_norm_g[i], w_uq[i], w_ukv[i])
        o_b = dsa_mixer(q_b, k_b, v_b, q_idx, k_idx, w_idx, positions)
        lam_init = 0.8 - 0.6 * math.exp(-0.3 * i)
        lam = (jnp.exp(jnp.sum(lam_q1[i].astype(f32) * lam_k1[i].astype(f32)))
               - jnp.exp(jnp.sum(lam_q2[i].astype(f32) * lam_k2[i].astype(f32))) + lam_init)
        o_c = diff_mixer(q_c, k_c, v_c, positions, lam, lam_init, subln_g[i])
        mixed = jnp.concatenate([o_a * jax.nn.silu(g_a),
                                 o_b * jax.nn.silu(g_b),
                                 o_c * jax.nn.silu(g_c)], axis=-1)
        h = h + mixed @ w_o[i]
        h = h + (p[i] @ w_ple[i]) * jax.nn.sigmoid(h @ w_pg[i])
    return rms_norm(h, final_g)
```

```cpp
#include <hip/hip_runtime.h>
#include <hip/hip_cooperative_groups.h>
#include <cstdio>
#include <cstdint>
namespace cg = cooperative_groups;

constexpr int NBATCH = 4, SEQ = 4096, TOK = NBATCH * SEQ, DM = 2048, DEPTH = 4, PLE = 256;
constexpr int DIN = 7176, NIN = 7168;
constexpr int NUQ = 1152, NUQP = 1280, KUQ = 384;
constexpr int NUKV = 1536, KUKV = 256;
constexpr int NTAB = 56;
constexpr float EPS = 1e-6f, LOG2E = 1.4426950408889634f;
constexpr float SC_A = 0.07216878364870322f * LOG2E;
constexpr float SC_B = 0.08838834764831845f * LOG2E;
constexpr float SC_C = 0.125f * LOG2E;

constexpr size_t al256(size_t x) { return (x + 255) & ~(size_t)255; }
constexpr size_t WS_CTRL = 0;
constexpr int CW_BAR = 4096, CTRL_WORDS = 8192;
constexpr size_t WS_SSQH = 65536;
constexpr size_t WS_SSQQ = WS_SSQH + (size_t)TOK * 32 * 4;
constexpr size_t WS_SSQKV = WS_SSQQ + (size_t)TOK * 12 * 4;
constexpr size_t WS_ZERO_END = WS_SSQKV + (size_t)TOK * 8 * 4;
constexpr size_t WS_TAB = al256(WS_ZERO_END);
constexpr size_t WS_WIN = al256(WS_TAB + (size_t)TOK * NTAB * 8);
constexpr size_t WS_WUQ = al256(WS_WIN + (size_t)DEPTH * NIN * DM * 2);
constexpr size_t WS_WUKV = al256(WS_WUQ + (size_t)DEPTH * NUQP * KUQ * 2);
constexpr size_t WS_WO = al256(WS_WUKV + (size_t)DEPTH * NUKV * KUKV * 2);
constexpr size_t WS_WPG = al256(WS_WO + (size_t)DEPTH * DM * DM * 2);
constexpr size_t WS_WPLE = al256(WS_WPG + (size_t)DEPTH * DM * DM * 2);
constexpr size_t WS_PB = al256(WS_WPLE + (size_t)DEPTH * DM * PLE * 2);
constexpr size_t WS_HB = al256(WS_PB + (size_t)DEPTH * TOK * PLE * 2);
constexpr size_t WS_HB2 = al256(WS_HB + (size_t)TOK * DM * 2);
constexpr size_t WS_PLEO = al256(WS_HB2 + (size_t)TOK * DM * 2);
constexpr size_t WS_CQ = al256(WS_PLEO + (size_t)TOK * DM * 2);
constexpr size_t WS_CKV = al256(WS_CQ + (size_t)TOK * 384 * 2);
constexpr size_t WS_KROPE = al256(WS_CKV + (size_t)TOK * 256 * 2);
constexpr size_t WS_KIDX = al256(WS_KROPE + (size_t)TOK * 64 * 2);
constexpr size_t WS_GATE = al256(WS_KIDX + (size_t)TOK * 64 * 2);
constexpr size_t WS_QKB = al256(WS_GATE + (size_t)TOK * DM * 2);
constexpr size_t WS_VBC = al256(WS_QKB + (size_t)TOK * 1280 * 2);
constexpr size_t WS_QKC = al256(WS_VBC + (size_t)TOK * 1280 * 2);
constexpr size_t WS_QI = al256(WS_QKC + (size_t)TOK * 1280 * 2);
constexpr size_t WS_WIDX = al256(WS_QI + (size_t)TOK * 512 * 2);
constexpr size_t WS_QMLA = al256(WS_WIDX + (size_t)TOK * 8 * 4);
constexpr size_t WS_KMLA = al256(WS_QMLA + (size_t)TOK * 1152 * 2);
constexpr size_t WS_VMLA = al256(WS_KMLA + (size_t)TOK * 768 * 2);
constexpr size_t WS_MASK = al256(WS_VMLA + (size_t)TOK * 768 * 2);
constexpr size_t WS_W8T = al256(WS_MASK + (size_t)TOK * 64 * 8);
constexpr size_t WS_SCR = al256(WS_W8T + (size_t)DEPTH * 16 * DM * 2);
constexpr size_t SCR_PER_BLOCK = 512 * 1024;
constexpr size_t WS_END = WS_SCR;
static_assert(WS_END <= (size_t)940572672, "workspace map exceeds 4 x largest tensor");

constexpr int LDS_MAIN = 131072, LDS_BYTES = LDS_MAIN + 1024;
#define LAS __attribute__((address_space(3)))
#ifndef REP_A2
#define REP_A2 1
#endif
#ifndef REP_SEL
#define REP_SEL 1
#endif
#ifndef REP_A01
#define REP_A01 1
#endif
#ifndef REP_G1
#define REP_G1 1
#endif
#ifndef REP_P0
#define REP_P0 1
#endif
#ifndef REP_SYNC
#define REP_SYNC 1
#endif

constexpr int LDS_WTAB = LDS_MAIN + 64;
__device__ __forceinline__ int opaque_tid() {
    const unsigned hw = __builtin_amdgcn_s_getreg((5 << 11) | 4) & 63u;
    const int w = __builtin_amdgcn_readfirstlane(*(volatile LAS int*)(uintptr_t)(LDS_WTAB + hw * 4));
    unsigned z = 0u; asm volatile("" : "+v"(z));
    const int lane = (int)__builtin_amdgcn_mbcnt_hi(~0u, __builtin_amdgcn_mbcnt_lo(~0u, z));
    return (w << 6) | lane;
}

namespace pg8 {
#define PG8_LAS __attribute__((address_space(3)))
typedef unsigned short bf16_t;
typedef short bf16x8 __attribute__((ext_vector_type(8)));
typedef float f32x4 __attribute__((ext_vector_type(4)));
typedef unsigned u32x4 __attribute__((ext_vector_type(4)));
constexpr int BM = 256, BK = 64, HALF = 128, HTB = HALF * BK * 2  , STAGE_BYTES = 8 * HTB, NXCD = 8, WGM = 8;

__host__ __device__ __forceinline__ int lds_byte(int r, int c) { const int st = (r >> 4) * 2 + (c >> 5), rr = r & 15, cc = c & 31, ob = rr * 64 + cc * 2; return st * 1024 + (ob ^ (((ob >> 9) & 1) << 5)); }
__host__ __device__ __forceinline__ void stage_rc(int b, int& R, int& C) { const int st = b / 1024, sb = b % 1024, swz = sb ^ (((sb >> 9) & 1) << 5); R = (st >> 1) * 16 + swz / 64; C = (st & 1) * 32 + (swz % 64) / 2; }
__host__ __device__ __forceinline__ int perm32(int rho) { const int n = rho >> 4, i = rho & 15; return 8 * (i >> 2) + 4 * n + (i & 3); }

struct Unit { int pm, pn; };
struct Gemm { const bf16_t* A; const bf16_t* Bt; int M, N, K; };

struct StaticOrder {
    int nM, nN, nwg, G, c;
    __host__ __device__ void init(int M, int N, int G_, int c_) { nM = M / BM; nN = N / BM; nwg = nM * nN; G = G_; c = c_; }
    __host__ __device__ bool next(int i, Unit& u) const {
        const long L = (long)i * G + c; if (L >= nwg) return false;
        int wgid = (int)L; { const int q = nwg / NXCD, r = nwg % NXCD, xcd = wgid % NXCD, off = wgid / NXCD; wgid = (xcd < r ? xcd * (q + 1) : r * (q + 1) + (xcd - r) * q) + off; }
        const int nig = WGM * nN, gid = wgid / nig, fm = gid * WGM, gsz = (nM - fm) < WGM ? (nM - fm) : WGM;
        u.pm = fm + ((wgid % nig) % gsz); u.pn = (wgid % nig) / gsz; return true;
    }
    __device__ __forceinline__ void a_ready(const Unit&) const {}
    __device__ __forceinline__ void done(const Unit&) const {}
};

__device__ __forceinline__ unsigned cvt_pk_bf16(float lo, float hi) { unsigned r; asm volatile("v_cvt_pk_bf16_f32 %0, %1, %2" : "=v"(r) : "v"(lo), "v"(hi)); return r; }
typedef float f32x2 __attribute__((ext_vector_type(2)));
typedef float2 tab_t;
__device__ __forceinline__ void rope8(float (&v)[8], const tab_t* tp) {
    const f32x4 t0 = *(const f32x4*)tp, t1 = *(const f32x4*)(tp + 2);
    const float c[4] = {t0[0], t0[2], t1[0], t1[2]}, s[4] = {t0[1], t0[3], t1[1], t1[3]};
#pragma unroll
    for (int j = 0; j < 4; ++j) { const float a = v[2 * j], b = v[2 * j + 1]; v[2 * j] = a * c[j] - b * s[j]; v[2 * j + 1] = b * c[j] + a * s[j]; }
}
__device__ __forceinline__ void store8(bf16_t* p, const float (&v)[8]) {
    u32x4 w; w.x = cvt_pk_bf16(v[0], v[1]); w.y = cvt_pk_bf16(v[2], v[3]); w.z = cvt_pk_bf16(v[4], v[5]); w.w = cvt_pk_bf16(v[6], v[7]);
    *(u32x4*)p = w;
}
template <int N4> __device__ __forceinline__ float sum_parts(const float* p) {
    f32x4 a = *(const f32x4*)p;
#pragma unroll
    for (int i = 1; i < N4; ++i) a += *(const f32x4*)(p + 4 * i);
    return (a[0] + a[1]) + (a[2] + a[3]);
}
__device__ __forceinline__ float silu_f(float x) { return x * __builtin_amdgcn_rcpf(1.0f + __builtin_amdgcn_exp2f(-x * 1.4426950408889634f)); }
__device__ __forceinline__ float sigmoid_f(float x) { return __builtin_amdgcn_rcpf(1.0f + __builtin_amdgcn_exp2f(-x * 1.4426950408889634f)); }

struct EpiIn {
    static constexpr bool PERM = true, AFTER_DRAIN = false;
    const float* ssq_h; float* ssq_q; float* ssq_kv;
    bf16_t *CQ, *CKV, *KROPE, *KIDX, *GATE, *QKB, *VBC, *QKC, *QI; const tab_t* TAB;
    __device__ __forceinline__ void operator()(const f32x4 (&acc)[2][2][4][2], const Unit& u, int wr, int wc, int fr, int fq) const {
        { const int t_ = opaque_tid(), w_ = __builtin_amdgcn_readfirstlane(t_ >> 6), l_ = t_ & 63; wr = w_ >> 2; wc = w_ & 3; fr = l_ & 15; fq = l_ >> 4; }
        const int pn = u.pn, row0 = u.pm * BM + wr * 64 + fr;
        bf16_t* dst[2]; int ld[2], tab[2], act[2], sld[2]; float sc[2]; float* ssq[2];
#pragma unroll
        for (int bj = 0; bj < 2; ++bj) {
            const int cc = bj * HALF + wc * 32 + fq * 8, n = pn * BM + cc;
            bf16_t* d = nullptr; int l = 0, col = 0, tb = -1, ac = 0, sl = 0; float s = 1.f; float* sq = nullptr;
            if (pn == 0) { d = CQ; l = 384; col = n; sq = ssq_q + bj * 4 + wc; sl = 12; }
            else if (pn == 1) {
                if (cc < 128) { d = CQ; l = 384; col = 256 + cc; sq = ssq_q + 8 + wc; sl = 12; }
                else if (cc < 192) { d = KROPE; l = 64; col = cc - 128; tb = (cc - 128) >> 1; }
                else { d = KIDX; l = 64; col = cc - 192; if (col < 16) tb = 48 + (col >> 1); }
            }
            else if (pn == 2) { d = CKV; l = 256; col = cc; sq = ssq_kv + bj * 4 + wc; sl = 8; }
            else if (pn < 11) { d = GATE; l = 2048; col = n - 768; ac = 1; }
            else if (pn < 16) { const int j = n - 2816; d = QKB; l = 1280; col = j; const int dd = j & 127; if (dd < 32) tb = 32 + (dd >> 1); if (j < 640) s = SC_B; }
            else if (pn < 21) { d = VBC; l = 1280; col = n - 4096; }
            else if (pn < 26) { const int j = n - 5376; d = QKC; l = 1280; col = j; const int dd = j & 63; if (dd < 16) tb = 48 + (dd >> 1); if (j < 640) s = SC_C; }
            else { const int j = n - 6656; d = QI; l = 512; col = j; const int dd = j & 63; if (dd < 16) tb = 48 + (dd >> 1); }
            dst[bj] = d + col; ld[bj] = l; tab[bj] = tb; act[bj] = ac; sld[bj] = sl; sc[bj] = s; ssq[bj] = sq;
        }
#pragma unroll
        for (int ai = 0; ai < 2; ++ai)
#pragma unroll
            for (int m = 0; m < 4; ++m) {
                const int row = row0 + ai * HALF + m * 16;
                const float r = __builtin_amdgcn_rsqf(sum_parts<8>(ssq_h + (size_t)row * 32) * (1.0f / 2048.0f) + 1e-6f);
#pragma unroll
                for (int bj = 0; bj < 2; ++bj) {
                    float v[8];
#pragma unroll
                    for (int e = 0; e < 4; ++e) { v[e] = acc[ai][bj][m][0][e] * r; v[4 + e] = acc[ai][bj][m][1][e] * r; }
                    if (tab[bj] >= 0) rope8(v, TAB + (size_t)row * NTAB + tab[bj]);
                    if (act[bj]) {
#pragma unroll
                        for (int e = 0; e < 8; ++e) v[e] = silu_f(v[e]);
                    }
#pragma unroll
                    for (int e = 0; e < 8; ++e) v[e] *= sc[bj];
                    if (ssq[bj]) { float s = 0.f;
#pragma unroll
                        for (int e = 0; e < 8; ++e) s += v[e] * v[e];
                        s += __shfl_xor(s, 16); s += __shfl_xor(s, 32);
                        if (fq == 0) ssq[bj][(size_t)row * sld[bj]] = s; }
                    store8(dst[bj] + (size_t)row * ld[bj], v);
                    asm volatile("" ::: "memory");
                }
            }
    }
};
struct EpiPlain {
    static constexpr bool PERM = true, AFTER_DRAIN = false;
    bf16_t* O; int ldc;
    __device__ __forceinline__ void operator()(const f32x4 (&acc)[2][2][4][2], const Unit& u, int wr, int wc, int fr, int fq) const {
        { const int t_ = opaque_tid(), w_ = __builtin_amdgcn_readfirstlane(t_ >> 6), l_ = t_ & 63; wr = w_ >> 2; wc = w_ & 3; fr = l_ & 15; fq = l_ >> 4; }
        const int row0 = u.pm * BM + wr * 64 + fr;
#pragma unroll
        for (int bj = 0; bj < 2; ++bj) { const int col = u.pn * BM + bj * HALF + wc * 32 + fq * 8;
#pragma unroll
            for (int ai = 0; ai < 2; ++ai)
#pragma unroll
                for (int m = 0; m < 4; ++m) { const int row = row0 + ai * HALF + m * 16; float v[8];
#pragma unroll
                    for (int e = 0; e < 4; ++e) { v[e] = acc[ai][bj][m][0][e]; v[4 + e] = acc[ai][bj][m][1][e]; }
                    store8(O + (size_t)row * ldc + col, v); } }
    }
};
struct EpiUq {
    static constexpr bool PERM = true, AFTER_DRAIN = false;
    const float* ssq; bf16_t* Q;
    __device__ __forceinline__ void operator()(const f32x4 (&acc)[2][2][4][2], const Unit& u, int wr, int wc, int fr, int fq) const {
        { const int t_ = opaque_tid(), w_ = __builtin_amdgcn_readfirstlane(t_ >> 6), l_ = t_ & 63; wr = w_ >> 2; wc = w_ & 3; fr = l_ & 15; fq = l_ >> 4; }
        const int row0 = u.pm * BM + wr * 64 + fr;
#pragma unroll
        for (int bj = 0; bj < 2; ++bj) { const int n = u.pn * BM + bj * HALF + wc * 32 + fq * 8;
            if (n < NUQ) {
#pragma unroll
            for (int ai = 0; ai < 2; ++ai)
#pragma unroll
                for (int m = 0; m < 4; ++m) { const int row = row0 + ai * HALF + m * 16;
                    const float r = __builtin_amdgcn_rsqf(sum_parts<3>(ssq + (size_t)row * 12) * (1.0f / 384.0f) + 1e-6f) * SC_A; float v[8];
#pragma unroll
                    for (int e = 0; e < 4; ++e) { v[e] = acc[ai][bj][m][0][e] * r; v[4 + e] = acc[ai][bj][m][1][e] * r; }
                    store8(Q + (size_t)row * NUQ + n, v); asm volatile("" ::: "memory"); } } }
    }
};
struct EpiUkv {
    static constexpr bool PERM = true, AFTER_DRAIN = false;
    const float* ssq; bf16_t* Kd; bf16_t* Vd;
    __device__ __forceinline__ void operator()(const f32x4 (&acc)[2][2][4][2], const Unit& u, int wr, int wc, int fr, int fq) const {
        { const int t_ = opaque_tid(), w_ = __builtin_amdgcn_readfirstlane(t_ >> 6), l_ = t_ & 63; wr = w_ >> 2; wc = w_ & 3; fr = l_ & 15; fq = l_ >> 4; }
        const int row0 = u.pm * BM + wr * 64 + fr;
        bf16_t* dst[2];
#pragma unroll
        for (int bj = 0; bj < 2; ++bj) { const int n = u.pn * BM + bj * HALF + wc * 32 + fq * 8; const int hd = n >> 8, d = n & 255; dst[bj] = (d < 128) ? (Kd + hd * 128 + d) : (Vd + hd * 128 + d - 128); }
#pragma unroll
        for (int ai = 0; ai < 2; ++ai)
#pragma unroll
            for (int m = 0; m < 4; ++m) { const int row = row0 + ai * HALF + m * 16;
                const float r = __builtin_amdgcn_rsqf(sum_parts<2>(ssq + (size_t)row * 8) * (1.0f / 256.0f) + 1e-6f);
#pragma unroll
                for (int bj = 0; bj < 2; ++bj) { float v[8];
#pragma unroll
                    for (int e = 0; e < 4; ++e) { v[e] = acc[ai][bj][m][0][e] * r; v[4 + e] = acc[ai][bj][m][1][e] * r; }
                    store8(dst[bj] + (size_t)row * 768, v); }
                asm volatile("" ::: "memory"); }
    }
};
struct EpiWo {
    static constexpr bool PERM = true, AFTER_DRAIN = false;
    const bf16_t* HBi; bf16_t* HBo;
    __device__ __forceinline__ void operator()(const f32x4 (&acc)[2][2][4][2], const Unit& u, int wr, int wc, int fr, int fq) const {
        { const int t_ = opaque_tid(), w_ = __builtin_amdgcn_readfirstlane(t_ >> 6), l_ = t_ & 63; wr = w_ >> 2; wc = w_ & 3; fr = l_ & 15; fq = l_ >> 4; }
        const int row0 = u.pm * BM + wr * 64 + fr;
#pragma unroll
        for (int bj = 0; bj < 2; ++bj) { const int col = u.pn * BM + bj * HALF + wc * 32 + fq * 8;
            u32x4 hw[2][4];
#pragma unroll
            for (int ai = 0; ai < 2; ++ai)
#pragma unroll
                for (int m = 0; m < 4; ++m) hw[ai][m] = *(const u32x4*)(HBi + (size_t)(row0 + ai * HALF + m * 16) * DM + col);
            asm volatile("" ::: "memory");
#pragma unroll
            for (int ai = 0; ai < 2; ++ai)
#pragma unroll
                for (int m = 0; m < 4; ++m) { const size_t off = (size_t)(row0 + ai * HALF + m * 16) * DM + col; float v[8];
#pragma unroll
                    for (int e2 = 0; e2 < 4; ++e2) { const unsigned g = hw[ai][m][e2];
                        const float a0 = (e2 < 2) ? acc[ai][bj][m][0][2 * e2] : acc[ai][bj][m][1][2 * e2 - 4], a1 = (e2 < 2) ? acc[ai][bj][m][0][2 * e2 + 1] : acc[ai][bj][m][1][2 * e2 - 3];
                        v[2 * e2] = __uint_as_float(g << 16) + a0; v[2 * e2 + 1] = __uint_as_float(g & 0xffff0000u) + a1; }
                    store8(HBo + off, v); }
            asm volatile("" ::: "memory"); }
    }
};
struct EpiPg {
    static constexpr bool PERM = true, AFTER_DRAIN = false;
    bf16_t* HBo; const bf16_t* P; float* ssq; const bf16_t* HBi;
    __device__ __forceinline__ void operator()(const f32x4 (&acc)[2][2][4][2], const Unit& u, int wr, int wc, int fr, int fq) const {
        { const int t_ = opaque_tid(), w_ = __builtin_amdgcn_readfirstlane(t_ >> 6), l_ = t_ & 63; wr = w_ >> 2; wc = w_ & 3; fr = l_ & 15; fq = l_ >> 4; }
        const int row0 = u.pm * BM + wr * 64 + fr;
#pragma unroll
        for (int ai = 0; ai < 2; ++ai) {
            float s[4] = {0.f, 0.f, 0.f, 0.f};
#pragma unroll
            for (int bj = 0; bj < 2; ++bj) { const int col = u.pn * BM + bj * HALF + wc * 32 + fq * 8;
                u32x4 hw[4], pw[4];
#pragma unroll
                for (int m = 0; m < 4; ++m) { const size_t off = (size_t)(row0 + ai * HALF + m * 16) * DM + col; hw[m] = *(const u32x4*)(HBi + off); pw[m] = *(const u32x4*)(P + off); }
                asm volatile("" ::: "memory");
#pragma unroll
                for (int m = 0; m < 4; ++m) { const size_t off = (size_t)(row0 + ai * HALF + m * 16) * DM + col; float v[8];
#pragma unroll
                    for (int e = 0; e < 4; ++e) {
                        const unsigned w = pw[m][e]; const float p0 = __uint_as_float(w << 16), p1 = __uint_as_float(w & 0xffff0000u);
                        const unsigned g = hw[m][e]; const float b0 = __uint_as_float(g << 16), b1 = __uint_as_float(g & 0xffff0000u);
                        const float a0 = (e < 2) ? acc[ai][bj][m][0][2 * e] : acc[ai][bj][m][1][2 * e - 4], a1 = (e < 2) ? acc[ai][bj][m][0][2 * e + 1] : acc[ai][bj][m][1][2 * e - 3];
                        v[2 * e] = b0 + p0 * sigmoid_f(a0); v[2 * e + 1] = b1 + p1 * sigmoid_f(a1); }
#pragma unroll
                    for (int e = 0; e < 8; ++e) s[m] += v[e] * v[e];
                    store8(HBo + off, v); }
                asm volatile("" ::: "memory"); }
#pragma unroll
            for (int m = 0; m < 4; ++m) { float t = s[m]; t += __shfl_xor(t, 16); t += __shfl_xor(t, 32);
                if (fq == 0) ssq[(size_t)(row0 + ai * HALF + m * 16) * 32 + u.pn * 4 + wc] = t; }
        }
    }
};
template <class Epi, class Sched, bool ALIGN_EPI = false, bool SP2 = false>
__device__ __forceinline__ void gemm_phase(PG8_LAS unsigned char* lds, const Gemm g, const Sched& S, const Epi& E) {
    const int tid = opaque_tid(), wid = __builtin_amdgcn_readfirstlane(tid >> 6), lane = tid & 63, wr = wid >> 2, wc = wid & 3, fr = lane & 15, fq = lane >> 4;
    const int K = g.K, nt = K / BK;
    unsigned voffA[2], voffB[2];
#pragma unroll
    for (int i = 0; i < 2; ++i) { int R, C; stage_rc(tid * 16 + i * 8192, R, C); const int Rb = Epi::PERM ? ((R & ~31) + perm32(R & 31)) : R;
        voffA[i] = (unsigned)(R * K + C) * 2u; voffB[i] = (unsigned)(Rb * K + C) * 2u; }
    const size_t kstep = (size_t)(BK * 2);
    const size_t hstep = (size_t)HALF * K * 2;
    const size_t tstep = 2 * hstep;
    const unsigned ldsw = (unsigned)wid * 1024u;
    const int aoff = lds_byte(wr * 64 + fr, fq * 8), boff = lds_byte(wc * 32 + fr, fq * 8);
#define PG8_SA(b, h) (((b) * 2 + (h)) * HTB)
#define PG8_SB(b, h) ((4 + (b) * 2 + (h)) * HTB)
#define PG8_STAGE(bufoff, gbase, voff) do { _Pragma("unroll") for (int _i = 0; _i < 2; ++_i) \
        __builtin_amdgcn_global_load_lds((const unsigned*)((const char*)(gbase) + (voff)[_i]), (PG8_LAS unsigned*)(lds + (bufoff) + ldsw + _i * 8192), 16, 0, 0); } while (0)
#define PG8_LDA(dst, b, h) do { _Pragma("unroll") for (int m = 0; m < 4; ++m) _Pragma("unroll") for (int k = 0; k < 2; ++k) dst[m][k] = *(const PG8_LAS bf16x8*)(lds + PG8_SA(b, h) + aoff + m * 2048 + k * 1024); } while (0)
#define PG8_LDB(dst, b, h) do { _Pragma("unroll") for (int n = 0; n < 2; ++n) _Pragma("unroll") for (int k = 0; k < 2; ++k) dst[n][k] = *(const PG8_LAS bf16x8*)(lds + PG8_SB(b, h) + boff + n * 2048 + k * 1024); } while (0)
#define PG8_MMA(ai, bj, At, Bt) do { __builtin_amdgcn_s_setprio(1); _Pragma("unroll") for (int m = 0; m < 4; ++m) _Pragma("unroll") for (int n = 0; n < 2; ++n) _Pragma("unroll") for (int k = 0; k < 2; ++k) \
        acc[ai][bj][m][n] = __builtin_amdgcn_mfma_f32_16x16x32_bf16(Bt[n][k], At[m][k], acc[ai][bj][m][n], 0, 0, 0); __builtin_amdgcn_s_setprio(0); } while (0)
#define PG8_WAIT_V(n) asm volatile("s_waitcnt vmcnt(" #n ")" ::: "memory")
#define PG8_WAIT_L(n) asm volatile("s_waitcnt lgkmcnt(" #n ")" ::: "memory")
#define PG8_BAR __builtin_amdgcn_s_barrier()
#define PG8_SCHED __builtin_amdgcn_sched_barrier(0)
    Unit cur, nxt; int ui = 0;
    if (!S.next(0, cur)) return;
    f32x4 acc[2][2][4][2];
#pragma unroll
    for (int a = 0; a < 2; ++a)
#pragma unroll
        for (int b = 0; b < 2; ++b)
#pragma unroll
            for (int m = 0; m < 4; ++m)
#pragma unroll
                for (int n = 0; n < 2; ++n) acc[a][b][m][n] = (f32x4){0.f, 0.f, 0.f, 0.f};
    bf16x8 At[4][2], B0[2][2], B1[2][2];
    const char* cA = (const char*)g.A + (size_t)cur.pm * tstep; const char* cB = (const char*)g.Bt + (size_t)cur.pn * tstep;
    S.a_ready(cur);
    if constexpr (SP2) {
        PG8_STAGE(PG8_SB(0, 0), cB, voffB); PG8_STAGE(PG8_SB(0, 1), cB + hstep, voffB); PG8_STAGE(PG8_SA(0, 0), cA, voffA); PG8_STAGE(PG8_SA(0, 1), cA + hstep, voffA);
        if (wr == 1) PG8_BAR;
        PG8_WAIT_V(2); PG8_BAR;
        PG8_STAGE(PG8_SB(1, 0), cB + kstep, voffB); PG8_STAGE(PG8_SA(1, 0), cA + kstep, voffA); PG8_STAGE(PG8_SB(1, 1), cB + hstep + kstep, voffB);
        PG8_WAIT_V(6); PG8_BAR;
    } else {
        PG8_STAGE(PG8_SB(0, 0), cB, voffB); PG8_STAGE(PG8_SA(0, 0), cA, voffA); PG8_STAGE(PG8_SB(0, 1), cB + hstep, voffB); PG8_STAGE(PG8_SA(0, 1), cA + hstep, voffA);
        if (wr == 1) PG8_BAR;
        PG8_WAIT_V(4); PG8_BAR;
        PG8_STAGE(PG8_SB(1, 0), cB + kstep, voffB); PG8_STAGE(PG8_SA(1, 0), cA + kstep, voffA); PG8_STAGE(PG8_SB(1, 1), cB + hstep + kstep, voffB);
        PG8_WAIT_V(6); PG8_BAR;
    }
    for (;;) {
        const bool has_next = S.next(ui + 1, nxt);
        const char* nA = has_next ? (const char*)g.A + (size_t)nxt.pm * tstep : cA; const char* nB = has_next ? (const char*)g.Bt + (size_t)nxt.pn * tstep : cB;
        for (int t = 0; t < nt; t += 2) {
            const bool last = (t == nt - 2);
            const char* a1 = cA + (size_t)(t + 1) * kstep;
            const char* a2 = last ? nA : cA + (size_t)(t + 2) * kstep; const char* b2 = last ? nB : cB + (size_t)(t + 2) * kstep;
            const char* a3 = a2 + kstep; const char* b3 = b2 + kstep;
            if (last && has_next) S.a_ready(nxt);
            if constexpr (SP2) {
            PG8_LDB(B0, 0, 0); PG8_LDB(B1, 0, 1); PG8_SCHED; PG8_LDA(At, 0, 0); PG8_STAGE(PG8_SA(1, 1), a1 + hstep, voffA);
            PG8_WAIT_V(8); PG8_WAIT_L(0); PG8_BAR; PG8_MMA(0, 0, At, B0); PG8_MMA(0, 1, At, B1); PG8_BAR; PG8_SCHED;
            PG8_LDA(At, 0, 1); PG8_STAGE(PG8_SB(0, 0), b2, voffB); PG8_STAGE(PG8_SB(0, 1), b2 + hstep, voffB); PG8_STAGE(PG8_SA(0, 0), a2, voffA);
            PG8_WAIT_V(8); PG8_WAIT_L(0); PG8_BAR; PG8_MMA(1, 0, At, B0); PG8_MMA(1, 1, At, B1); PG8_BAR; PG8_SCHED;
            PG8_LDB(B0, 1, 0); PG8_LDB(B1, 1, 1); PG8_SCHED; PG8_LDA(At, 1, 0); PG8_STAGE(PG8_SA(0, 1), a2 + hstep, voffA);
            PG8_WAIT_V(8); PG8_WAIT_L(0); PG8_BAR; PG8_MMA(0, 0, At, B0); PG8_MMA(0, 1, At, B1); PG8_BAR; PG8_SCHED;
            PG8_LDA(At, 1, 1); PG8_STAGE(PG8_SB(1, 0), b3, voffB); PG8_STAGE(PG8_SB(1, 1), b3 + hstep, voffB); PG8_STAGE(PG8_SA(1, 0), a3, voffA);
            PG8_WAIT_V(8); PG8_WAIT_L(0); PG8_BAR; PG8_MMA(1, 0, At, B0); PG8_MMA(1, 1, At, B1); PG8_BAR; PG8_SCHED;
            } else {
            PG8_LDB(B0, 0, 0); PG8_SCHED; PG8_LDA(At, 0, 0); PG8_STAGE(PG8_SA(1, 1), a1 + hstep, voffA);
            PG8_WAIT_L(8); PG8_BAR; PG8_WAIT_L(0); PG8_MMA(0, 0, At, B0); PG8_BAR; PG8_SCHED;
            PG8_LDB(B1, 0, 1); PG8_STAGE(PG8_SB(0, 0), b2, voffB);
            PG8_BAR; PG8_WAIT_L(0); PG8_MMA(0, 1, At, B1); PG8_BAR;
            PG8_LDA(At, 0, 1); PG8_STAGE(PG8_SA(0, 0), a2, voffA);
            PG8_BAR; PG8_WAIT_L(0); PG8_MMA(1, 0, At, B0); PG8_BAR; PG8_SCHED;
            PG8_STAGE(PG8_SB(0, 1), b2 + hstep, voffB);
            PG8_WAIT_V(6); PG8_BAR; PG8_MMA(1, 1, At, B1); PG8_BAR;
            PG8_LDB(B0, 1, 0); PG8_SCHED; PG8_LDA(At, 1, 0); PG8_STAGE(PG8_SA(0, 1), a2 + hstep, voffA);
            PG8_WAIT_L(8); PG8_BAR; PG8_WAIT_L(0); PG8_MMA(0, 0, At, B0); PG8_BAR; PG8_SCHED;
            PG8_LDB(B1, 1, 1); PG8_STAGE(PG8_SB(1, 0), b3, voffB);
            PG8_BAR; PG8_WAIT_L(0); PG8_MMA(0, 1, At, B1); PG8_BAR;
            PG8_LDA(At, 1, 1); PG8_STAGE(PG8_SA(1, 0), a3, voffA);
            PG8_BAR; PG8_WAIT_L(0); PG8_MMA(1, 0, At, B0); PG8_BAR; PG8_SCHED;
            PG8_STAGE(PG8_SB(1, 1), b3 + hstep, voffB);
            PG8_WAIT_V(6); PG8_BAR; PG8_MMA(1, 1, At, B1); PG8_BAR;
            }
        }
        if constexpr (ALIGN_EPI) { if (wr == 0) PG8_BAR; }
        if constexpr (!Epi::AFTER_DRAIN) { E(acc, cur, wr, wc, fr, fq); S.done(cur); }
        if (!has_next) break;
#pragma unroll
        for (int a = 0; a < 2; ++a)
#pragma unroll
            for (int b = 0; b < 2; ++b)
#pragma unroll
                for (int m = 0; m < 4; ++m)
#pragma unroll
                    for (int n = 0; n < 2; ++n) acc[a][b][m][n] = (f32x4){0.f, 0.f, 0.f, 0.f};
        cur = nxt; cA = nA; cB = nB; ++ui;
        if constexpr (ALIGN_EPI) { if (wr == 1) PG8_BAR; }
    }
    PG8_WAIT_V(0);
    if constexpr (!ALIGN_EPI) { if (wr == 0) PG8_BAR; }
    PG8_BAR;
    if constexpr (Epi::AFTER_DRAIN) { E.fused(acc, cur, wr, wc, fr, fq, lds, wid, lane); S.done(cur); }
#undef PG8_SA
#undef PG8_SB
#undef PG8_STAGE
#undef PG8_LDA
#undef PG8_LDB
#undef PG8_MMA
#undef PG8_WAIT_V
#undef PG8_WAIT_L
#undef PG8_BAR
#undef PG8_SCHED
}
}
namespace att {
typedef short bf16x8 __attribute__((ext_vector_type(8)));
typedef short s16x4 __attribute__((ext_vector_type(4)));
typedef float f32x16 __attribute__((ext_vector_type(16)));
typedef float f32x4 __attribute__((ext_vector_type(4)));
typedef unsigned u32x4 __attribute__((ext_vector_type(4)));
typedef unsigned u32x2 __attribute__((ext_vector_type(2)));
typedef unsigned short bf16_t;
typedef LAS const char* lptr;
constexpr int ST_K = 0, ST_V = 16384, ST_K64 = 32768, ST_BYTES = 40960;

__device__ __forceinline__ unsigned offb(unsigned row, unsigned ch) { return 256u * row + 16u * (ch ^ (((row & 3) << 2) | ((row >> 2) & 3))); }
__device__ __forceinline__ unsigned off64(unsigned row, unsigned ch) { return 128u * row + 16u * (ch ^ ((row >> 1) & 7)); }
__device__ __forceinline__ unsigned cvtpk(float lo, float hi) { unsigned r; asm("v_cvt_pk_bf16_f32 %0, %1, %2" : "=v"(r) : "v"(lo), "v"(hi)); return r; }
__device__ __forceinline__ s16x4 vtr(lptr p) { typedef short v4i16_t __attribute__((ext_vector_type(4))); return __builtin_bit_cast(s16x4, __builtin_amdgcn_ds_read_tr16_b64_v4i16((LAS v4i16_t*)p)); }
__device__ __forceinline__ float bf_lo(unsigned w) { return __uint_as_float(w << 16); }
__device__ __forceinline__ float bf_hi(unsigned w) { return __uint_as_float(w & 0xffff0000u); }

template <bool MASKED>
__device__ __forceinline__ void softmax_tile(f32x16& s0, f32x16& s1, float& m, float& l, float& alpha, unsigned mlo, unsigned mhi, bf16x8 (&pk)[4]) {
    const float NEG = -1e30f;
    if (MASKED) {
#pragma unroll
        for (int r = 0; r < 16; ++r) { const int bit = (r & 3) + 8 * (r >> 2); if (!((mlo >> bit) & 1u)) s0[r] = NEG; if (!((mhi >> bit) & 1u)) s1[r] = NEG; }
    }
    float mx = fmaxf(s0[0], s1[0]);
#pragma unroll
    for (int r = 1; r < 16; ++r) mx = fmaxf(mx, fmaxf(s0[r], s1[r]));
    mx = fmaxf(mx, __shfl_xor(mx, 32));
    const float mn = fmaxf(m, mx);
    alpha = __builtin_amdgcn_exp2f(m - mn); m = mn;
    float sum = 0.f;
#pragma unroll
    for (int r = 0; r < 16; ++r) {
        float p0 = __builtin_amdgcn_exp2f(s0[r] - mn), p1 = __builtin_amdgcn_exp2f(s1[r] - mn);
        if (MASKED) { if (s0[r] <= -1e29f) p0 = 0.f; if (s1[r] <= -1e29f) p1 = 0.f; }
        s0[r] = p0; s1[r] = p1; sum += p0 + p1;
    }
    l = l * alpha + sum;
#pragma unroll
    for (int k2 = 0; k2 < 2; ++k2) {
        u32x4 a, b;
        a.x = cvtpk(s0[8 * k2 + 0], s0[8 * k2 + 1]); a.y = cvtpk(s0[8 * k2 + 2], s0[8 * k2 + 3]); a.z = cvtpk(s0[8 * k2 + 4], s0[8 * k2 + 5]); a.w = cvtpk(s0[8 * k2 + 6], s0[8 * k2 + 7]);
        b.x = cvtpk(s1[8 * k2 + 0], s1[8 * k2 + 1]); b.y = cvtpk(s1[8 * k2 + 2], s1[8 * k2 + 3]); b.z = cvtpk(s1[8 * k2 + 4], s1[8 * k2 + 5]); b.w = cvtpk(s1[8 * k2 + 6], s1[8 * k2 + 7]);
        pk[k2] = __builtin_bit_cast(bf16x8, a); pk[2 + k2] = __builtin_bit_cast(bf16x8, b);
    }
}

struct AttnPtrs {
    const bf16_t* Q; int ldq;
    const bf16_t* K; int ldk;
    const bf16_t* K64;
    const bf16_t* V; int ldv;
    const bf16_t* G; bf16_t* Go;
    const unsigned long long* MASK;
    float lam, c_out; const float* subg;
};

template <int MODE>
__device__ __forceinline__ void attn_unit(LAS char* lds, const AttnPtrs& A, int b, int qb) {
    constexpr int NQ = (MODE == 0) ? 12 : (MODE == 1 ? 8 : 4);
    const int tid = opaque_tid(), lane = tid & 63, r32 = lane & 31, hi = lane >> 5, wid = __builtin_amdgcn_readfirstlane(tid >> 6);
    const int strm = (MODE == 2) ? (wid & 1) : 0;
    const size_t rowbase = (size_t)b * SEQ; const int q0 = (MODE == 2) ? qb * 128 + (wid >> 1) * 32 : qb * 256 + wid * 32; const int cw = q0 >> 6, NT = (MODE == 2) ? 2 * qb + 2 : 4 * qb + 4;
    const size_t qrow = rowbase + q0 + r32;
    bf16x8 qf[NQ];
#pragma unroll
    for (int s = 0; s < NQ; ++s) qf[s] = *(const bf16x8*)(A.Q + qrow * A.ldq + 64 * strm + 16 * s + 8 * hi);
    if constexpr (MODE == 0) {
#pragma unroll
        for (int s = 0; s < 4; ++s) {
            const u32x4 w = __builtin_bit_cast(u32x4, qf[8 + s]);
            const f32x4 t0 = *(const f32x4*)(A.subg + (qrow * 56 + 8 * s + 4 * hi) * 2), t1 = *(const f32x4*)(A.subg + (qrow * 56 + 8 * s + 4 * hi) * 2 + 4);
            u32x4 o;
            { const float a = bf_lo(w.x), b = bf_hi(w.x); o.x = cvtpk(a * t0[0] - b * t0[1], b * t0[0] + a * t0[1]); }
            { const float a = bf_lo(w.y), b = bf_hi(w.y); o.y = cvtpk(a * t0[2] - b * t0[3], b * t0[2] + a * t0[3]); }
            { const float a = bf_lo(w.z), b = bf_hi(w.z); o.z = cvtpk(a * t1[0] - b * t1[1], b * t1[0] + a * t1[1]); }
            { const float a = bf_lo(w.w), b = bf_hi(w.w); o.w = cvtpk(a * t1[2] - b * t1[3], b * t1[2] + a * t1[3]); }
            qf[8 + s] = __builtin_bit_cast(bf16x8, o);
        }
    }
#pragma unroll
    for (int s = 0; s < NQ; ++s) asm volatile("" :: "v"(qf[s]));
    const bf16_t* ksrc[2]; const bf16_t* vsrc[2];
#pragma unroll
    for (int i = 0; i < 2; ++i) { const unsigned row = 4u * (2 * wid + i) + (lane >> 4), ch = (lane & 15) ^ (((row & 3) << 2) | ((row >> 2) & 3));
        ksrc[i] = A.K + (rowbase + row) * A.ldk + ch * 8; vsrc[i] = A.V + (rowbase + row) * A.ldv + ch * 8; }
    const bf16_t* k64src = nullptr;
    if constexpr (MODE == 0) { const unsigned row = 8u * wid + (lane >> 3), ch = (lane & 7) ^ ((row >> 1) & 7); k64src = A.K64 + (rowbase + row) * 64 + ch * 8; }
    const unsigned fK = ((r32 & 3) << 2) | ((r32 >> 2) & 3);
    const unsigned g64 = (r32 >> 1) & 7;
    const int q4 = (lane & 15) >> 2, p4 = lane & 3, blk = (lane >> 4) & 1;
    unsigned vrow[2], vlow[2];
#pragma unroll
    for (int t = 0; t < 2; ++t) { vrow[t] = 4 * hi + 8 * t + q4; vlow[t] = (unsigned)((2 * blk + (p4 >> 1)) ^ ((hi + 2 * t) & 3)); }
#define DMA16(src_, ldsoff_) __builtin_amdgcn_global_load_lds((const unsigned*)(src_), (LAS unsigned*)(lds + (ldsoff_)), 16, 0, 0)
    constexpr int STB = (MODE == 0) ? ST_BYTES : 32768;
#define STAGE(t_, st_) do { const size_t o_ = (size_t)(t_) * 64; const int sb_ = (st_) * STB + wid * 2048; \
        DMA16(ksrc[0] + o_ * A.ldk, sb_ + ST_K); DMA16(ksrc[1] + o_ * A.ldk, sb_ + ST_K + 1024); \
        DMA16(vsrc[0] + o_ * A.ldv, sb_ + ST_V); DMA16(vsrc[1] + o_ * A.ldv, sb_ + ST_V + 1024); \
        if constexpr (MODE == 0) DMA16(k64src + o_ * 64, (st_) * STB + ST_K64 + wid * 1024); } while (0)
    f32x16 o1[4];
#pragma unroll
    for (int c = 0; c < 4; ++c) o1[c] = f32x16{};
    float m1 = -1e30f, l1 = 0.f;
    unsigned long long mw_next = 0ull;
    if constexpr (MODE == 1) { mw_next = A.MASK[qrow * 64]; asm volatile("" : "+v"(mw_next)); }
    bf16x8 pk[4]; float a1 = 1.f;
#define KFRAG(S_, K0_, K1_) do { if ((S_) < 8) { const unsigned ad_ = 256u * r32 + 16u * ((unsigned)(2 * (S_) + hi + 8 * strm) ^ fK); \
                K0_ = *(const LAS bf16x8*)(sb + ST_K + ad_); K1_ = *(const LAS bf16x8*)(sb + ST_K + ad_ + 8192); } \
            else { const unsigned ad_ = 128u * r32 + 16u * ((unsigned)(2 * ((S_) - 8) + hi) ^ g64); \
                K0_ = *(const LAS bf16x8*)(sb + ST_K64 + ad_); K1_ = *(const LAS bf16x8*)(sb + ST_K64 + ad_ + 4096); } } while (0)
#define QK_PASS(NS_) do { _Pragma("unroll") for (int b_ = 0; b_ < (NS_); b_ += 4) { bf16x8 ka[4], kb[4]; \
                _Pragma("unroll") for (int i_ = 0; i_ < 4; ++i_) KFRAG(b_ + i_, ka[i_], kb[i_]); \
                __builtin_amdgcn_sched_barrier(0); \
                _Pragma("unroll") for (int i_ = 0; i_ < 4; ++i_) { s0 = __builtin_amdgcn_mfma_f32_32x32x16_bf16(ka[i_], qf[b_ + i_], s0, 0, 0, 0); s1 = __builtin_amdgcn_mfma_f32_32x32x16_bf16(kb[i_], qf[b_ + i_], s1, 0, 0, 0); } \
                __builtin_amdgcn_sched_barrier(0); } } while (0)
#define VTR_ASM(DST_, ADDR_) asm volatile("ds_read_b64_tr_b16 %0, %1" : "=v"(DST_) : "v"(ADDR_))
#define PV_PASS(SB_) do { if (__any(a1 != 1.f)) { _Pragma("unroll") for (int c = 0; c < 4; ++c) o1[c] *= a1; } \
            const unsigned vb_ = (unsigned)(uintptr_t)(SB_) + ST_V + 8u * (p4 & 1); \
            _Pragma("unroll") for (int b_ = 0; b_ < 16; b_ += 8) { s16x4 vl[8], vh[8]; \
                _Pragma("unroll") for (int i_ = 0; i_ < 8; ++i_) { const int c_ = (b_ + i_) >> 2, ks_ = (b_ + i_) & 3; const unsigned chi_ = (unsigned)((c_ ^ q4) << 2); \
                    VTR_ASM(vl[i_], vb_ + 256u * (16 * ks_ + vrow[0]) + 16u * (chi_ | vlow[0])); \
                    VTR_ASM(vh[i_], vb_ + 256u * (16 * ks_ + vrow[1]) + 16u * (chi_ | vlow[1])); } \
                asm volatile("s_waitcnt lgkmcnt(0)" ::: "memory"); __builtin_amdgcn_sched_barrier(0); \
                _Pragma("unroll") for (int i_ = 0; i_ < 8; ++i_) { const s16x4 lo = vl[i_], h4 = vh[i_]; \
                    const bf16x8 vf = (bf16x8){lo[0], lo[1], lo[2], lo[3], h4[0], h4[1], h4[2], h4[3]}; \
                    o1[(b_ + i_) >> 2] = __builtin_amdgcn_mfma_f32_32x32x16_bf16(vf, pk[(b_ + i_) & 3], o1[(b_ + i_) >> 2], 0, 0, 0); } \
                __builtin_amdgcn_sched_barrier(0); } } while (0)
#define WAIT_TILE(all_) do { if (all_) asm volatile("s_waitcnt vmcnt(0) lgkmcnt(0)" ::: "memory"); \
        else if constexpr (MODE == 0) asm volatile("s_waitcnt vmcnt(5) lgkmcnt(0)" ::: "memory"); else asm volatile("s_waitcnt vmcnt(4) lgkmcnt(0)" ::: "memory"); \
        __builtin_amdgcn_s_barrier(); asm volatile("" ::: "memory"); } while (0)
    if constexpr (MODE == 2) {
        STAGE(0, 0); STAGE(1, 1);
        asm volatile("s_waitcnt vmcnt(0) lgkmcnt(0)" ::: "memory"); __builtin_amdgcn_s_barrier(); asm volatile("" ::: "memory");
        for (int t = 0; t < NT; t += 2) {
            if (t + 2 < NT) { STAGE(t + 2, (t + 2) & 3); STAGE(t + 3, (t + 3) & 3); }
#pragma unroll
            for (int u2 = 0; u2 < 2; ++u2) {
                if (t + u2 <= cw) {
                    const lptr sb = (lptr)(lds + ((t + u2) & 3) * STB);
                    f32x16 s0 = f32x16{}, s1 = f32x16{};
                    QK_PASS(NQ);
                    softmax_tile<false>(s0, s1, m1, l1, a1, 0, 0, pk);
                    PV_PASS(sb);
                }
            }
            asm volatile("s_waitcnt vmcnt(0) lgkmcnt(0)" ::: "memory"); __builtin_amdgcn_s_barrier(); asm volatile("" ::: "memory");
        }
    } else {
    STAGE(0, 0); STAGE(1, 1);
    WAIT_TILE(false);
    int st_cur = 0, st_nn = 2;
    for (int t = 0; t < NT; ++t) {
        unsigned mlo = 0, mhi = 0;
        if constexpr (MODE == 1) { if (t <= cw) {
            const unsigned long long w = mw_next; mlo = (unsigned)w >> (4 * hi); mhi = (unsigned)(w >> 32) >> (4 * hi);
            asm volatile("" : "+v"(mlo), "+v"(mhi));
            if (t < cw) { const unsigned long long* mp_ = A.MASK + qrow * 64 + t + 1; asm volatile("global_load_dwordx2 %0, %1, off" : "+v"(mw_next) : "v"(mp_) : "memory"); } } }
        const bool more2 = (t + 2 < NT);
        if (more2) STAGE(t + 2, st_nn);
        if (t <= cw) {
            const lptr sb = (lptr)(lds + st_cur * STB);
            f32x16 s0 = f32x16{}, s1 = f32x16{};
            QK_PASS(NQ);
            if constexpr (MODE == 1) softmax_tile<true>(s0, s1, m1, l1, a1, mlo, mhi, pk); else softmax_tile<false>(s0, s1, m1, l1, a1, 0, 0, pk);
            PV_PASS(sb);
        }
        WAIT_TILE(!more2);
        st_cur = (st_cur == 2) ? 0 : st_cur + 1; st_nn = (st_nn == 2) ? 0 : st_nn + 1;
    }
    }
#undef WAIT_TILE
#undef PV_PASS
#undef QK_PASS
#undef VTR_ASM
#undef KFRAG
    l1 += __shfl_xor(l1, 32); const float i1 = 1.0f / l1;
    float rstd = 1.f;
    if constexpr (MODE == 2) {
        LAS float* xb = (LAS float*)lds + (wid >> 1) * 4096 + lane;
        if (strm == 1) { const float i2 = A.lam * i1;
#pragma unroll
            for (int c = 0; c < 4; ++c)
#pragma unroll
                for (int r = 0; r < 16; ++r) xb[(c * 16 + r) * 64] = o1[c][r] * i2; }
        __syncthreads();
        if (strm == 0) { float ss = 0.f;
#pragma unroll
            for (int c = 0; c < 4; ++c)
#pragma unroll
                for (int r = 0; r < 16; ++r) { const float v = o1[c][r] * i1 - xb[(c * 16 + r) * 64]; o1[c][r] = v; ss += v * v; }
            ss += __shfl_xor(ss, 32); rstd = __builtin_amdgcn_rsqf(ss * (1.0f / 128.0f) + 1e-6f) * A.c_out; }
        __syncthreads();
        if (strm == 1) return;
    }
    const bf16_t* grow = A.G + qrow * 2048; bf16_t* orow = A.Go + qrow * 2048;
#pragma unroll
    for (int c = 0; c < 4; ++c)
#pragma unroll
        for (int rr = 0; rr < 4; ++rr) {
            const int dv = 32 * c + 8 * rr + 4 * hi;
            const u32x2 g = *(const u32x2*)(grow + dv);
            float v[4];
#pragma unroll
            for (int e = 0; e < 4; ++e) v[e] = o1[c][4 * rr + e];
            if (MODE == 2) { const f32x4 sg = *(const f32x4*)(A.subg + dv);
#pragma unroll
                for (int e = 0; e < 4; ++e) v[e] *= rstd * sg[e]; }
            else {
#pragma unroll
                for (int e = 0; e < 4; ++e) v[e] *= i1; }
            u32x2 w; w.x = cvtpk(v[0] * bf_lo(g.x), v[1] * bf_hi(g.x)); w.y = cvtpk(v[2] * bf_lo(g.y), v[3] * bf_hi(g.y));
            *(u32x2*)(orow + dv) = w;
        }
}
#undef STAGE
#undef DMA16
}
namespace sel {
using att::bf16x8; using att::u32x4; using att::bf16_t; using att::f32x4;
constexpr int L_QI = 0, L_HIST = 16384, L_PART = 32768 + 64,     L_PREF = L_PART + 2048, L_KREM = L_PREF + 64, L_NEQ = L_KREM + 64, L_FLAG = L_NEQ + 64, L_W = L_FLAG + 64;
__device__ __forceinline__ unsigned fkey(float f) { const unsigned u = __float_as_uint(f); return (u & 0x80000000u) ? ~u : (u | 0x80000000u); }

__device__ __forceinline__ void scan_hist(LAS char* lds, int shiftbits) {
    LAS unsigned* hist = (LAS unsigned*)(lds + L_HIST); LAS unsigned* part = (LAS unsigned*)(lds + L_PART);
    LAS unsigned* pref = (LAS unsigned*)(lds + L_PREF); LAS unsigned* kremS = (LAS unsigned*)(lds + L_KREM); LAS unsigned* neqS = (LAS unsigned*)(lds + L_NEQ);
    const int tid = opaque_tid(), q = tid & 15, g = tid >> 4;
    unsigned hv[8]; unsigned s = 0;
#pragma unroll
    for (int j = 0; j < 8; ++j) { hv[j] = hist[(8 * g + j) * 16 + q]; s += hv[j]; }
    const unsigned krem = kremS[q];
    part[g * 16 + q] = s;
    __syncthreads();
    unsigned above = 0;
#pragma unroll
    for (int gg = 0; gg < 32; ++gg) { const unsigned pv = part[gg * 16 + q]; above += (gg > g) ? pv : 0u; }
    if (above < krem && krem <= above + s) {
        unsigned cum = above; int bsel = 8 * g; unsigned hsel = 0; bool done = false;
#pragma unroll
        for (int j = 7; j >= 0; --j) { if (!done) { if (cum + hv[j] >= krem) { bsel = 8 * g + j; hsel = hv[j]; done = true; } else cum += hv[j]; } }
        pref[q] = (pref[q] << shiftbits) | (unsigned)bsel; kremS[q] = krem - cum; neqS[q] = hsel;
    }
    __syncthreads();
}
#define SEL_HADD(idx_) __hip_atomic_fetch_add(&hist[(idx_)], 1u, __ATOMIC_RELAXED, __HIP_MEMORY_SCOPE_WORKGROUP)

__device__ __forceinline__ void sel_unit(LAS char* lds, int b, int u, const bf16_t* QI, const bf16_t* KIDX, const float* WIDX, unsigned long long* MASK) {
    const int tid = opaque_tid(), lane = tid & 63, q16 = lane & 15, kg = lane >> 4, wid = __builtin_amdgcn_readfirstlane(tid >> 6);
    const size_t rowbase = (size_t)b * SEQ; const int q0 = u * 16, c = q0 >> 6;
    const size_t gq = rowbase + q0 + q16;
    if (c <= 3) {
        unsigned ones = 0xffffffffu; asm volatile("" : "+v"(ones));
        for (int i = tid; i < 16 * (c + 1); i += 512) { unsigned* mp = (unsigned*)(MASK + (rowbase + q0 + (i & 15)) * 64 + (i >> 4)); mp[0] = ones; mp[1] = ones; }
        return;
    }
    LAS unsigned* hist = (LAS unsigned*)(lds + L_HIST);
    LAS unsigned* pref = (LAS unsigned*)(lds + L_PREF); LAS unsigned* kremS = (LAS unsigned*)(lds + L_KREM); LAS unsigned* neqS = (LAS unsigned*)(lds + L_NEQ);
#pragma unroll
    for (int i = 0; i < 2; ++i) { const int id = tid + 512 * i, row = id >> 6, ch = id & 63;
        *(LAS u32x4*)(lds + L_QI + row * 1024 + ((ch ^ (row & 15)) << 4)) = *(const u32x4*)(QI + (rowbase + q0 + row) * 512 + ch * 8); }
    for (int i = tid; i < 4096; i += 512) hist[i] = 0u;
    if (tid < 16) { pref[tid] = 0u; kremS[tid] = 256u; }
    if (tid < 128) ((LAS float*)(lds + L_W))[tid] = WIDX[(rowbase + q0 + (tid & 15)) * 8 + (tid >> 4)];
    const LAS float* wl = (const LAS float*)(lds + L_W) + q16;
    __syncthreads();
    const int nj = (c - wid + 8) >> 3;
    u32x4 sc[8][4];
#pragma unroll
    for (int j = 0; j < 8; ++j) {
        if (j < nj) {
            int t = wid + 8 * j; asm volatile("" : "+s"(t));
#pragma unroll
            for (int kh = 0; kh < 2; ++kh) {
            bf16x8 kf[2][2];
#pragma unroll
            for (int kb = 0; kb < 2; ++kb)
#pragma unroll
                for (int ks = 0; ks < 2; ++ks) kf[kb][ks] = *(const bf16x8*)(KIDX + (rowbase + 64 * t + 32 * kh + 16 * kb + q16) * 64 + 32 * ks + 8 * kg);
#pragma unroll
            for (int kb = 0; kb < 2; ++kb) {
                f32x4 s = (f32x4){0.f, 0.f, 0.f, 0.f};
#pragma unroll
                for (int hh = 0; hh < 8; ++hh) {
                    f32x4 a = (f32x4){0.f, 0.f, 0.f, 0.f};
#pragma unroll
                    for (int ks = 0; ks < 2; ++ks) {
                        const bf16x8 qv = *(const LAS bf16x8*)(lds + L_QI + q16 * 1024 + (((hh * 8 + 4 * ks + kg) ^ q16) << 4));
                        a = __builtin_amdgcn_mfma_f32_16x16x32_bf16(kf[kb][ks], qv, a, 0, 0, 0);
                    }
                    const float wh = wl[hh * 16];
#pragma unroll
                    for (int i = 0; i < 4; ++i) s[i] += wh * fmaxf(a[i], 0.f);
                }
                u32x4 kk; kk.x = fkey(s[0]); kk.y = fkey(s[1]); kk.z = fkey(s[2]); kk.w = fkey(s[3]);
                sc[j][2 * kh + kb] = kk;
#pragma unroll
                for (int i = 0; i < 4; ++i) SEL_HADD((kk[i] >> 24) * 16 + q16);
                __builtin_amdgcn_sched_barrier(0);
            }
            asm volatile("" ::: "memory");
            }
        }
    }
#define SEL_TILE(j_) (wid + 8 * (j_))
    __syncthreads();
    scan_hist(lds, 8);
#pragma unroll 1
    for (int pass = 1; pass < 4; ++pass) {
        const int shift = 24 - 8 * pass;
        { const int t_ = opaque_tid(); for (int i = t_; i < 4096; i += 512) hist[i] = 0u; }
        __syncthreads();
        const unsigned pf = pref[q16];
        unsigned zz = 0u; asm volatile("" : "+v"(zz));
#pragma unroll
        for (int j = 0; j < 8; ++j) if (j < nj) {
#pragma unroll
            for (int kb = 0; kb < 4; ++kb)
#pragma unroll
                for (int i = 0; i < 4; ++i) { const unsigned k = sc[j][kb][i] | zz; SEL_HADD((((k >> (shift + 8)) == pf) ? ((k >> shift) & 255u) * 16 : 4096u) + q16); __builtin_amdgcn_sched_barrier(0); }
        }
        __syncthreads();
        scan_hist(lds, 8);
    }
    const unsigned kstar = pref[q16]; unsigned vthr = 0u;
    {
        LAS unsigned* flag = (LAS unsigned*)(lds + L_FLAG);
        const int t3 = opaque_tid();
        if (t3 == 0) flag[0] = 0u;
        __syncthreads();
        if (t3 < 16 && neqS[t3] > kremS[t3]) flag[0] = 1u;
        __syncthreads();
        if (flag[0]) {
            if (t3 < 16) pref[t3] = 0u;
#pragma unroll 1
            for (int pass = 0; pass < 2; ++pass) {
                { const int t_ = opaque_tid(); for (int i = t_; i < 4096; i += 512) hist[i] = 0u; }
                __syncthreads();
                const unsigned pf = pref[q16];
                unsigned zz = 0u; asm volatile("" : "+v"(zz));
#pragma unroll
                for (int j = 0; j < 8; ++j) if (j < nj) {
#pragma unroll
                    for (int kb = 0; kb < 4; ++kb)
#pragma unroll
                        for (int i = 0; i < 4; ++i) { const unsigned k = sc[j][kb][i] | zz;
                            const unsigned v = (4095u - (unsigned)(64 * SEL_TILE(j) + 16 * kb + 4 * (int)(__builtin_amdgcn_mbcnt_hi(~0u, __builtin_amdgcn_mbcnt_lo(~0u, zz)) >> 4) + i)) | zz;
                            SEL_HADD(((k == kstar && (pass == 0 || (v >> 4) == pf)) ? (pass == 0 ? (v >> 4) : (v & 15u)) * 16 : 4096u) + q16); __builtin_amdgcn_sched_barrier(0); }
                }
                __syncthreads();
                scan_hist(lds, pass == 0 ? 8 : 4);
            }
            vthr = pref[q16];
        }
    }
    const int tid2 = opaque_tid(), kg2 = (tid2 & 63) >> 4; const size_t gq2 = rowbase + q0 + (tid2 & 15);
#pragma unroll
    for (int j = 0; j < 8; ++j) if (j < nj) {
        const int t = SEL_TILE(j);
        unsigned lo = 0u, hi = 0u;
#pragma unroll
        for (int kb = 0; kb < 4; ++kb)
#pragma unroll
            for (int i = 0; i < 4; ++i) { const unsigned k = sc[j][kb][i]; const unsigned kin = 16 * kb + 4 * kg2 + i;
                const unsigned v = 4095u - (unsigned)(64 * t + kin);
                const unsigned s = ((k > kstar) || (k == kstar && v >= vthr)) ? 1u : 0u;
                if (kb < 2) lo |= s << kin; else hi |= s << (kin - 32); __builtin_amdgcn_sched_barrier(0); }
        { auto r = __builtin_amdgcn_permlane32_swap(lo, lo, false, false); lo = r[0] | r[1]; r = __builtin_amdgcn_permlane16_swap(lo, lo, false, false); lo = r[0] | r[1];
          r = __builtin_amdgcn_permlane32_swap(hi, hi, false, false); hi = r[0] | r[1]; r = __builtin_amdgcn_permlane16_swap(hi, hi, false, false); hi = r[0] | r[1]; }
        if (kg2 == 0) MASK[gq2 * 64 + t] = ((unsigned long long)hi << 32) | lo;
    }
    __syncthreads();
}
#undef SEL_HADD
#undef SEL_TILE
}
typedef unsigned short bf16;
typedef unsigned v4u __attribute__((ext_vector_type(4)));
typedef float f32x4 __attribute__((ext_vector_type(4)));
__device__ __forceinline__ unsigned f2bf(float f) { unsigned u = __builtin_bit_cast(unsigned, f); return (u + 0x7fffu + ((u >> 16) & 1u)) >> 16; }
__device__ __forceinline__ unsigned pk2(float lo, float hi) { return f2bf(lo) | (f2bf(hi) << 16); }
__device__ __forceinline__ float wave_sum(float v) {
#pragma unroll
    for (int o = 1; o < 64; o <<= 1) v += __shfl_xor(v, o);
    return v;
}
__device__ __forceinline__ int pairperm(int d, int nrot) { return d < nrot ? ((d & 1) ? (nrot / 2 + (d >> 1)) : (d >> 1)) : d; }
__device__ __forceinline__ int colmap_in(int n) {
    if (n < 384) return n;
    if (n < 448) return 640 + pairperm(n - 384, 64);
    if (n < 512) return 3904 + pairperm(n - 448, 16);
    if (n < 768) return 384 + (n - 512);
    if (n < 2816) { const int j = n - 768; return j < 768 ? 704 + j : (j < 1408 ? 3976 + (j - 768) : 6536 + (j - 1408)); }
    if (n < 4096) { const int j = n - 2816, w = j / 640, r = j % 640; return (w ? 2112 : 1472) + (r & ~127) + pairperm(r & 127, 32); }
    if (n < 5376) { const int j = n - 4096; return j < 640 ? 2752 + j : 5896 + (j - 640); }
    if (n < 6656) { const int j = n - 5376, w = j / 640, r = j % 640; return (w ? 5256 : 4616) + (r & ~63) + pairperm(r & 63, 16); }
    if (n < 7168) { const int j = n - 6656; return 3392 + (j & ~63) + pairperm(j & 63, 16); }
    return -1;
}
__device__ __forceinline__ int colmap_uq(int n) { if (n >= NUQ) return -1; const int hd = n / 192, d = n % 192; return hd * 192 + (d < 128 ? d : 128 + pairperm(d - 128, 64)); }
template <int MAP>
__device__ __forceinline__ void transpose_item(const float* W, int K, int Nsrc, int Ndst, bf16* WT, const float* gain, LAS float* scr, int item, int lane) {
    const int nblk = Ndst / 32, kb = item / nblk, nb = item % nblk, k0 = 64 * kb, n0 = 32 * nb;
    const int nn = n0 + (lane & 31); const int sc = MAP == 0 ? nn : (MAP == 1 ? colmap_in(nn) : colmap_uq(nn));
    float wv_[32];
#pragma unroll
    for (int i = 0; i < 32; ++i) { const int kk = 2 * i + (lane >> 5); wv_[i] = (sc >= 0) ? W[(size_t)(k0 + kk) * Nsrc + sc] : 0.f; }
#pragma unroll
    for (int i = 0; i < 32; ++i) { const int kk = 2 * i + (lane >> 5); float v = wv_[i]; if (gain) v *= gain[k0 + kk]; scr[kk * 33 + (lane & 31)] = v; }
    asm volatile("s_waitcnt lgkmcnt(0)" ::: "memory");
    const int c = lane & 7;
#pragma unroll
    for (int j = 0; j < 4; ++j) { const int n = (lane >> 3) + 8 * j; const LAS float* s = scr + (8 * c) * 33 + n;
        v4u o; o.x = pk2(s[0 * 33], s[1 * 33]); o.y = pk2(s[2 * 33], s[3 * 33]); o.z = pk2(s[4 * 33], s[5 * 33]); o.w = pk2(s[6 * 33], s[7 * 33]);
        *(v4u*)(WT + (size_t)(n0 + n) * K + k0 + 8 * c) = o; }
    asm volatile("s_waitcnt lgkmcnt(0)" ::: "memory");
}

struct Args {
    const float *x, *p; const int* pos; const float *w_in, *w_uq, *w_ukv, *w_o, *norm_g, *q_norm_g, *kv_norm_g, *lam_q1, *lam_k1, *lam_q2, *lam_k2, *subln_g, *w_ple, *w_pg, *final_g;
    float* out; unsigned char* ws;
};

__device__ __forceinline__ int fetch_item(unsigned* ctr, LAS unsigned* slot_unused) {
    unsigned sa = (unsigned)LDS_MAIN; asm volatile("" : "+v"(sa));
    LAS unsigned* slot = (LAS unsigned*)(uintptr_t)sa;
    __syncthreads();
    if (opaque_tid() == 0) *slot = atomicAdd(ctr, 1u);
    __syncthreads();
    return __builtin_amdgcn_readfirstlane((int)*slot);
}

typedef const __attribute__((address_space(4))) Args* argp_t;
#define OPQ_WS() argp_t ap = (argp_t)__builtin_amdgcn_kernarg_segment_ptr(); asm volatile("" : "+s"(ap)); unsigned char* ws = ap->ws
#define ctrl ((unsigned*)(ws + WS_CTRL))
#define ssqh ((float*)(ws + WS_SSQH))
#define ssqq ((float*)(ws + WS_SSQQ))
#define ssqkv ((float*)(ws + WS_SSQKV))
#define TAB ((pg8::tab_t*)(ws + WS_TAB))
#define WIN ((bf16*)(ws + WS_WIN))
#define WUQ ((bf16*)(ws + WS_WUQ))
#define WUKV ((bf16*)(ws + WS_WUKV))
#define WO ((bf16*)(ws + WS_WO))
#define WPG ((bf16*)(ws + WS_WPG))
#define WPLE ((bf16*)(ws + WS_WPLE))
#define PB ((bf16*)(ws + WS_PB))
#define HB ((bf16*)(ws + WS_HB))
#define HB2 ((bf16*)(ws + WS_HB2))
#define PLEO ((bf16*)(ws + WS_PLEO))
#define CQ ((bf16*)(ws + WS_CQ))
#define CKV ((bf16*)(ws + WS_CKV))
#define KROPE ((bf16*)(ws + WS_KROPE))
#define KIDX ((bf16*)(ws + WS_KIDX))
#define GATE ((bf16*)(ws + WS_GATE))
#define QKB ((bf16*)(ws + WS_QKB))
#define VBC ((bf16*)(ws + WS_VBC))
#define QKC ((bf16*)(ws + WS_QKC))
#define QI ((bf16*)(ws + WS_QI))
#define WIDX ((float*)(ws + WS_WIDX))
#define QMLA ((bf16*)(ws + WS_QMLA))
#define KMLA ((bf16*)(ws + WS_KMLA))
#define VMLA ((bf16*)(ws + WS_VMLA))
#define MASK ((unsigned long long*)(ws + WS_MASK))
#define W8T ((bf16*)(ws + WS_W8T))
#define SCR ((float*)(ws + WS_SCR + (size_t)bx * SCR_PER_BLOCK))

template <int PH, int SUB = 15>
__device__ __forceinline__ void run_phase(const int L) {
    extern __shared__ __attribute__((aligned(16))) unsigned char lds_raw[];
    LAS unsigned char* lds = (LAS unsigned char*)lds_raw;
    LAS unsigned* slot = (LAS unsigned*)(lds + LDS_MAIN);
    const int G = gridDim.x, bx = blockIdx.x;
    if constexpr (PH == 0) {
    for (int rep0 = 0; rep0 < REP_P0; ++rep0)
    {
        OPQ_WS();
        const int tid = opaque_tid(), lane = tid & 63, wave = __builtin_amdgcn_readfirstlane(tid >> 6);
        const int gt = bx * 512 + tid, NGT = G * 512, gw = bx * 8 + wave, NGW = G * 8;
        for (int i = gt; i < CTRL_WORDS; i += NGT) ctrl[i] = 0u;
        LAS float* scr = (LAS float*)(lds + wave * 8704);
        constexpr int I_IN = (DM / 64) * (NIN / 32), I_UQ = (KUQ / 64) * (NUQP / 32), I_UKV = (KUKV / 64) * (NUKV / 32), I_SQ = (DM / 64) * (DM / 32), I_PLE = (PLE / 64) * (DM / 32);
        constexpr int I_L = I_IN + I_UQ + I_UKV + 2 * I_SQ + I_PLE;
        for (int it = gw; it < DEPTH * I_L; it += NGW) {
            const int L = it / I_L; int r = it % I_L;
            if (r < I_IN) { transpose_item<1>(ap->w_in + (size_t)L * DM * DIN, DM, DIN, NIN, WIN + (size_t)L * NIN * DM, ap->norm_g + L * DM, scr, r, lane); continue; } r -= I_IN;
            if (r < I_UQ) { transpose_item<2>(ap->w_uq + (size_t)L * KUQ * NUQ, KUQ, NUQ, NUQP, WUQ + (size_t)L * NUQP * KUQ, ap->q_norm_g + L * KUQ, scr, r, lane); continue; } r -= I_UQ;
            if (r < I_UKV) { transpose_item<0>(ap->w_ukv + (size_t)L * KUKV * NUKV, KUKV, NUKV, NUKV, WUKV + (size_t)L * NUKV * KUKV, ap->kv_norm_g + L * KUKV, scr, r, lane); continue; } r -= I_UKV;
            if (r < I_SQ) { transpose_item<0>(ap->w_o + (size_t)L * DM * DM, DM, DM, DM, WO + (size_t)L * DM * DM, nullptr, scr, r, lane); continue; } r -= I_SQ;
            if (r < I_SQ) { transpose_item<0>(ap->w_pg + (size_t)L * DM * DM, DM, DM, DM, WPG + (size_t)L * DM * DM, nullptr, scr, r, lane); continue; } r -= I_SQ;
            transpose_item<0>(ap->w_ple + (size_t)L * PLE * DM, PLE, DM, DM, WPLE + (size_t)L * DM * PLE, nullptr, scr, r, lane);
        }
        for (int i = gt; i < DEPTH * 16 * DM; i += NGT) { const int Lw = i / (16 * DM), c = (i / DM) & 15, k = i % DM;
            W8T[i] = (bf16)((c < 8) ? f2bf(ap->w_in[((size_t)Lw * DM + k) * DIN + 3968 + c] * ap->norm_g[Lw * DM + k]) : 0u); }
        { const int n8 = DEPTH * TOK * PLE / 8;
#pragma unroll 4
          for (int i = gt; i < n8; i += NGT) { const f32x4 v0 = *(const f32x4*)(ap->p + (size_t)i * 8), v1 = *(const f32x4*)(ap->p + (size_t)i * 8 + 4);
              v4u o; o.x = pk2(v0[0], v0[1]); o.y = pk2(v0[2], v0[3]); o.z = pk2(v1[0], v1[1]); o.w = pk2(v1[2], v1[3]); *(v4u*)(PB + (size_t)i * 8) = o; } }
        for (int m = gw; m < TOK; m += NGW) {
            const f32x4* xr = (const f32x4*)(ap->x + (size_t)m * DM) + lane; float s = 0.f;
            unsigned long long* o8 = (unsigned long long*)(HB + (size_t)m * DM) + lane;
#pragma unroll
            for (int j = 0; j < 8; ++j) { const f32x4 v = xr[64 * j]; s += (v[0] * v[0] + v[1] * v[1]) + (v[2] * v[2] + v[3] * v[3]);
                o8[64 * j] = (unsigned long long)pk2(v[0], v[1]) | ((unsigned long long)pk2(v[2], v[3]) << 32); }
            s = wave_sum(s); if (lane < 32) ssqh[(size_t)m * 32 + lane] = (lane == 0) ? s : 0.f;
        }
        for (int i = gt; i < TOK * NTAB; i += NGT) {
            const int t = i / NTAB, j = i % NTAB; int nrot, fi; if (j < 32) { nrot = 64; fi = j; } else if (j < 48) { nrot = 32; fi = j - 32; } else { nrot = 16; fi = j - 48; }
            const float e = (float)fi * (2.0f / (float)nrot); const float invf = 1.0f / powf(500000.0f, e);
            const float ang = (float)ap->pos[t] * invf; const double rev = (double)ang * 0.15915494309189535; const float fr = (float)(rev - floor(rev));
            TAB[i] = make_float2(__builtin_amdgcn_cosf(fr), __builtin_amdgcn_sinf(fr));
        }
    }

    }
    if constexpr (PH == 1) {
    for (int rep1 = 0; rep1 < REP_G1; ++rep1)
        {
            OPQ_WS();
            pg8::Gemm g{HB, WIN + (size_t)L * NIN * DM, TOK, NIN, DM}; pg8::StaticOrder S; S.init(TOK, NIN, G, bx);
            pg8::EpiIn E{ssqh, ssqq, ssqkv, CQ, CKV, KROPE, KIDX, GATE, QKB, VBC, QKC, QI, TAB};
#ifndef NO_G1
            pg8::gemm_phase<pg8::EpiIn, pg8::StaticOrder, true, true>(lds, g, S, E);
#endif
            pg8::Gemm g2{PB + (size_t)L * TOK * PLE, WPLE + (size_t)L * DM * PLE, TOK, DM, PLE}; pg8::StaticOrder S2; S2.init(TOK, DM, G, (bx + 64) % G);
            pg8::EpiPlain E2{PLEO, DM};
#ifndef NO_G1B
            pg8::gemm_phase<pg8::EpiPlain, pg8::StaticOrder, true, true>(lds, g2, S2, E2);
#endif
            {
                const int tid = opaque_tid(), lane = tid & 63, wave = __builtin_amdgcn_readfirstlane(tid >> 6);
                for (int grp = bx * 8 + wave; grp < TOK / 16; grp += G * 8) {
                    const bf16* pa = HB + (size_t)(grp * 16 + (lane & 15)) * DM + 8 * (lane >> 4);
                    const bf16* pb = W8T + ((size_t)L * 16 + (lane & 15)) * DM + 8 * (lane >> 4);
                    f32x4 acc = (f32x4){0.f, 0.f, 0.f, 0.f};
#pragma unroll 16
                    for (int s = 0; s < DM / 32; ++s) acc = __builtin_amdgcn_mfma_f32_16x16x32_bf16(*(const att::bf16x8*)(pa + 32 * s), *(const att::bf16x8*)(pb + 32 * s), acc, 0, 0, 0);
                    if ((lane & 15) < 8) {
#pragma unroll
                        for (int i = 0; i < 4; ++i) { const int row = grp * 16 + 4 * (lane >> 4) + i;
                            const float r = __builtin_amdgcn_rsqf(pg8::sum_parts<8>(ssqh + (size_t)row * 32) * (1.0f / 2048.0f) + 1e-6f);
                            WIDX[(size_t)row * 8 + (lane & 15)] = acc[i] * r; }
                    }
                }
            }
        }
    }
    if constexpr (PH == 2) {
        {
            OPQ_WS();
            if constexpr (SUB & 1) {
            { pg8::Gemm g{CQ, WUQ + (size_t)L * NUQP * KUQ, TOK, NUQP, KUQ}; pg8::StaticOrder S; S.init(TOK, NUQP, G, bx);
              pg8::EpiUq E{ssqq, QMLA};

#ifndef NO_G2
              pg8::gemm_phase<pg8::EpiUq, pg8::StaticOrder, true, false>(lds, g, S, E);
#endif
 }
            }
            if constexpr (SUB & 8) {
            { pg8::Gemm g{CKV, WUKV + (size_t)L * NUKV * KUKV, TOK, NUKV, KUKV}; pg8::StaticOrder S; S.init(TOK, NUKV, G, (bx + 64) % G);
              pg8::EpiUkv E{ssqkv, KMLA, VMLA};

#ifndef NO_G2B
              pg8::gemm_phase<pg8::EpiUkv, pg8::StaticOrder, true, true>(lds, g, S, E);
#endif
 }
            }
            if constexpr (SUB & 2) {
            float s1 = 0.f, s2 = 0.f;
            for (int i = 0; i < 64; ++i) { s1 += ap->lam_q1[L * 64 + i] * ap->lam_k1[L * 64 + i]; s2 += ap->lam_q2[L * 64 + i] * ap->lam_k2[L * 64 + i]; }
            const float lam_init = 0.8f - 0.6f * expf(-0.3f * (float)L); const float lam = expf(s1) - expf(s2) + lam_init;
            for (int rep = 0; rep < REP_A2; ++rep)
            { unsigned* ctr = ctrl + L * 32 + 0 + 4 * rep;
              for (;;) {
                const int it = fetch_item(ctr, slot);
                if (it >= 640) break;
                const int qb = 31 - it / 20, bh = it % 20, b = bh / 5, h = bh % 5;
                att::AttnPtrs A{QKC + 2 * h * 64, 1280, QKC + 640 + 2 * h * 64, 1280, nullptr, VBC + 640 + h * 128, 1280, GATE + 1408 + h * 128, GATE + 1408 + h * 128, nullptr, lam, 1.0f - lam_init, ap->subln_g + L * 128};
#ifndef NO_A2
                att::attn_unit<2>((LAS char*)lds, A, b, qb);
#endif
              } }
            }
            if constexpr (SUB & 4)
            for (int rep = 0; rep < REP_SEL; ++rep)
            { unsigned* ctr = ctrl + L * 32 + 1 + 4 * rep;
              for (;;) {
                const int j = fetch_item(ctr, slot);
                if (j >= 1024) break;
                const int u = 255 - j / 4, b = j % 4;
#ifndef NO_SEL
                sel::sel_unit((LAS char*)lds, b, u, QI, KIDX, WIDX, MASK);
#endif
              } }
        }
    }
    if constexpr (PH == 3) {
        {
            OPQ_WS();
            for (int rep = 0; rep < REP_A01; ++rep) {
            unsigned* ctr = ctrl + L * 32 + 2 + 4 * rep;
            for (;;) {
                const int it = fetch_item(ctr, slot);
                if (it >= 704) break;
                const int qb = 15 - it / 44, w = it % 44;
                if (w < 24) { const int b = w / 6, h = w % 6;
                    att::AttnPtrs A{QMLA + h * 192, NUQ, KMLA + h * 128, 768, KROPE, VMLA + h * 128, 768, GATE + h * 128, GATE + h * 128, nullptr, 0.f, 0.f, (const float*)TAB};
#ifndef NO_A0
                    att::attn_unit<0>((LAS char*)lds, A, b, qb);
#endif
                } else { const int w2 = w - 24, b = w2 / 5, h = w2 % 5;
                    att::AttnPtrs A{QKB + h * 128, 1280, QKB + 640 + h * 128, 1280, nullptr, VBC + h * 128, 1280, GATE + 768 + h * 128, GATE + 768 + h * 128, MASK, 0.f, 0.f, nullptr};
#ifndef NO_A1
                    att::attn_unit<1>((LAS char*)lds, A, b, qb);
#endif
                }
            }
            }
        }
    }
    if constexpr (PH == 4) {
        {
            OPQ_WS();
            pg8::Gemm g{GATE, WO + (size_t)L * DM * DM, TOK, DM, DM};     pg8::StaticOrder S; S.init(TOK, DM, G, bx);
            pg8::EpiWo E{HB, HB2};
#ifndef NO_G4
            pg8::gemm_phase<pg8::EpiWo, pg8::StaticOrder, true, true>(lds, g, S, E);
#endif
        }
    }
    if constexpr (PH == 5) {
        {
            OPQ_WS();
            pg8::Gemm g{HB2, WPG + (size_t)L * DM * DM, TOK, DM, DM}; pg8::StaticOrder S; S.init(TOK, DM, G, bx);
            pg8::EpiPg E{HB, PLEO, ssqh, HB2};
#ifndef NO_G5
            pg8::gemm_phase<pg8::EpiPg, pg8::StaticOrder, true, true>(lds, g, S, E);
#endif
        }
    }
    if constexpr (PH == 6) {
    {
        OPQ_WS();
        const int tid = opaque_tid();
        const int gt = bx * 512 + tid, NGT = G * 512; const float* ss = ssqh;
        for (int i = gt; i < TOK * DM / 4; i += NGT) { const int row = i / (DM / 4), c4 = i % (DM / 4);
            const float r = __builtin_amdgcn_rsqf(pg8::sum_parts<8>(ss + (size_t)row * 32) * (1.0f / 2048.0f) + 1e-6f); const f32x4 gv = *(const f32x4*)(ap->final_g + c4 * 4);
            const unsigned long long hw = *(const unsigned long long*)(HB + (size_t)i * 4); const unsigned w0 = (unsigned)hw, w1 = (unsigned)(hw >> 32);
            f32x4 v = (f32x4){__uint_as_float(w0 << 16), __uint_as_float(w0 & 0xffff0000u), __uint_as_float(w1 << 16), __uint_as_float(w1 & 0xffff0000u)}; v = v * r * gv; *(f32x4*)(ap->out + (size_t)i * 4) = v; }
    }
    }
}
__device__ __forceinline__ void init_wave_table() {
    extern __shared__ __attribute__((aligned(16))) unsigned char lds_raw[];
    const unsigned hw = __builtin_amdgcn_s_getreg((5 << 11) | 4) & 63u;
    if ((threadIdx.x & 63) == 0) { *(volatile LAS int*)(uintptr_t)(LDS_WTAB + hw * 4) = (int)(threadIdx.x >> 6); if (threadIdx.x == 0x7fffffff) lds_raw[0] = 0; }
    if (threadIdx.x == 0) { *(volatile LAS unsigned*)(uintptr_t)(LDS_MAIN + 16) = 0u; *(volatile LAS unsigned*)(uintptr_t)(LDS_MAIN + 20) = 0u; }
    __syncthreads();
}
#define RLX_AGENT __ATOMIC_RELAXED, __HIP_MEMORY_SCOPE_AGENT
#define XB_TMO      128
#define XB_XCNT(j)  (256  + 64 * (j))
#define XB_XSUB(j)  (1280 + 64 * (j))
#define XB_XGEN(j)  (2304 + 64 * (j))
#define XB_TOP      3328
#define XB_TOPGEN   3392
#define XCD_BAR_WORDS 3456
#define XB_SPIN_CAP (1u << 18)

__device__ __forceinline__ unsigned xb_ld(unsigned* p)              { return __hip_atomic_load(p, __ATOMIC_RELAXED, __HIP_MEMORY_SCOPE_AGENT); }
__device__ __forceinline__ unsigned xb_add(unsigned* p, unsigned v) { return __hip_atomic_fetch_add(p, v, __ATOMIC_RELAXED, __HIP_MEMORY_SCOPE_AGENT); }
__device__ __forceinline__ unsigned xb_xcc_id() { return (unsigned)__builtin_amdgcn_s_getreg((3 << 11) | 20) & 0xFu; }
#define XB_SPIN(cond, bar) do { unsigned _sp = 0; while (cond) { __builtin_amdgcn_s_sleep(1); \
    if ((++_sp & 255u) == 0u) { if (xb_ld(&(bar)[XB_TMO])) break; if (_sp > XB_SPIN_CAP) { atomicAdd(&(bar)[XB_TMO], 1u); break; } } } } while (0)

struct XcdBarrier {
    unsigned* bar; unsigned x;
    volatile LAS unsigned* st;
};

__device__ __forceinline__ XcdBarrier xcd_barrier_post(unsigned* bar, volatile LAS unsigned* st) {
    XcdBarrier b; b.bar = bar; b.x = xb_xcc_id(); b.st = st;
    if (opaque_tid() == 0) (void)xb_add(&bar[XB_XCNT(b.x)], 1u);
    return b;
}
__device__ __forceinline__ void xcd_barrier_complete(unsigned* bar, unsigned x, unsigned& nloc, unsigned& nx) {
    const unsigned G = gridDim.x * gridDim.y * gridDim.z;
    unsigned sum, cnt, mine, sp = 0u;
    for (;;) {
        sum = 0u; cnt = 0u; mine = 0u;
#pragma unroll
        for (unsigned j = 0; j < 16; ++j) { const unsigned c = xb_ld(&bar[XB_XCNT(j)]); sum += c; cnt += (c > 0u) ? 1u : 0u; mine = (j == x) ? c : mine; }
        if (sum == G) break;
        __builtin_amdgcn_s_sleep(1);
        if ((++sp & 255u) == 0u) { if (xb_ld(&bar[XB_TMO])) break; if (sp > XB_SPIN_CAP) { atomicAdd(&bar[XB_TMO], 1u); break; } }
    }
    nloc = mine > 0u ? mine : 1u; nx = cnt > 0u ? cnt : 1u;
}

__device__ __forceinline__ void xcd_barrier(const XcdBarrier& b) {
    asm volatile("s_waitcnt vmcnt(0)" ::: "memory");
    __syncthreads();
    if (opaque_tid() == 0) {
        unsigned* bar = b.bar;
        __builtin_amdgcn_s_waitcnt(0);
        unsigned nloc = b.st[0], nx = b.st[1];
        if (nloc == 0u) { xcd_barrier_complete(bar, b.x, nloc, nx); b.st[0] = nloc; b.st[1] = nx; }
        const unsigned old = xb_add(&bar[XB_XSUB(b.x)], 1u);
        const unsigned gen = old / nloc;
        if (old + 1u == (gen + 1u) * nloc) {
            __builtin_amdgcn_fence(__ATOMIC_RELEASE, "agent");
            asm volatile("s_waitcnt vmcnt(0)" ::: "memory");
            const unsigned og = xb_add(&bar[XB_TOP], 1u);
            const unsigned tg = og / nx;
            if (og + 1u == (tg + 1u) * nx) xb_add(&bar[XB_TOPGEN], 1u);
            else XB_SPIN(xb_ld(&bar[XB_TOPGEN]) == tg, bar);
            __builtin_amdgcn_fence(__ATOMIC_ACQUIRE, "agent");
            xb_add(&bar[XB_XGEN(b.x)], 1u);
            asm volatile("s_waitcnt vmcnt(0)" ::: "memory");
        } else {
            XB_SPIN(xb_ld(&bar[XB_XGEN(b.x)]) == gen, bar);
            __builtin_amdgcn_fence(__ATOMIC_ACQUIRE, "agent");
            asm volatile("s_waitcnt vmcnt(0)" ::: "memory");
        }
    }
    __syncthreads();
}

#ifdef MULTI_LAUNCH
template <int PH, int SUB> __global__ void __launch_bounds__(512, 2) k_phase(Args a_kernarg, int L) { init_wave_table(); run_phase<PH, SUB>(L); }
#else
__global__ void __launch_bounds__(512, 2) hybrid_fwd(Args a_kernarg) {
    cg::grid_group grid = cg::this_grid();
    init_wave_table();
    run_phase<0>(0);
    grid.sync();
#define XBAR_MAKE() argp_t apb = (argp_t)__builtin_amdgcn_kernarg_segment_ptr(); asm volatile("" : "+s"(apb)); unsigned* barw = (unsigned*)(apb->ws + WS_CTRL) + CW_BAR
    { XBAR_MAKE(); (void)xcd_barrier_post(barw, (volatile LAS unsigned*)(uintptr_t)(LDS_MAIN + 16)); }
#define GSYNC() do { XBAR_MAKE(); XcdBarrier xb_; xb_.bar = barw; xb_.x = xb_xcc_id(); xb_.st = (volatile LAS unsigned*)(uintptr_t)(LDS_MAIN + 16); for (int rs_ = 0; rs_ < REP_SYNC; ++rs_) xcd_barrier(xb_); } while (0)
    for (int L = 0; L < DEPTH; ++L) {
        run_phase<1>(L); GSYNC();
        run_phase<2>(L); GSYNC();
        run_phase<3>(L); GSYNC();
        run_phase<4>(L); GSYNC();
        run_phase<5>(L); GSYNC();
    }
    run_phase<6>(0);
}
#endif

extern "C" void kernel_launch(void* const* d_in, const int* in_sizes, int n_in, void* d_out, int out_size, void* d_ws, size_t ws_size, hipStream_t stream) {
    static int grid = 0;
    if (grid == 0) {
        if (n_in != 18 || out_size != TOK * DM || ws_size < WS_END) { fprintf(stderr, "kernel_launch: unexpected shapes (n_in %d out %d ws %zu need %zu)\n", n_in, out_size, ws_size, (size_t)WS_END); grid = -1; return; }
        int dev = 0, cus = 0;
        (void)hipGetDevice(&dev); (void)hipDeviceGetAttribute(&cus, hipDeviceAttributeMultiprocessorCount, dev);
#ifdef MULTI_LAUNCH
        (void)hipFuncSetAttribute((const void*)k_phase<0, 7>, hipFuncAttributeMaxDynamicSharedMemorySize, LDS_BYTES);
        (void)hipFuncSetAttribute((const void*)k_phase<1, 7>, hipFuncAttributeMaxDynamicSharedMemorySize, LDS_BYTES);
        (void)hipFuncSetAttribute((const void*)k_phase<2, 1>, hipFuncAttributeMaxDynamicSharedMemorySize, LDS_BYTES);
        (void)hipFuncSetAttribute((const void*)k_phase<2, 8>, hipFuncAttributeMaxDynamicSharedMemorySize, LDS_BYTES);
        (void)hipFuncSetAttribute((const void*)k_phase<2, 2>, hipFuncAttributeMaxDynamicSharedMemorySize, LDS_BYTES);
        (void)hipFuncSetAttribute((const void*)k_phase<2, 4>, hipFuncAttributeMaxDynamicSharedMemorySize, LDS_BYTES);
        (void)hipFuncSetAttribute((const void*)k_phase<3, 7>, hipFuncAttributeMaxDynamicSharedMemorySize, LDS_BYTES);
        (void)hipFuncSetAttribute((const void*)k_phase<4, 7>, hipFuncAttributeMaxDynamicSharedMemorySize, LDS_BYTES);
        (void)hipFuncSetAttribute((const void*)k_phase<5, 7>, hipFuncAttributeMaxDynamicSharedMemorySize, LDS_BYTES);
        (void)hipFuncSetAttribute((const void*)k_phase<6, 7>, hipFuncAttributeMaxDynamicSharedMemorySize, LDS_BYTES);
#else
        int per_cu = 0;
        (void)hipFuncSetAttribute((const void*)hybrid_fwd, hipFuncAttributeMaxDynamicSharedMemorySize, LDS_BYTES);
        (void)hipOccupancyMaxActiveBlocksPerMultiprocessor(&per_cu, (const void*)hybrid_fwd, 512, LDS_BYTES);
        if (per_cu < 1) fprintf(stderr, "kernel_launch: occupancy query says %d blocks per CU\n", per_cu);
#endif
        (void)hipGetLastError();
        grid = cus > 256 ? 256 : cus;
    }
    if (grid < 0) return;
    Args a{};
    a.x = (const float*)d_in[0]; a.p = (const float*)d_in[1]; a.pos = (const int*)d_in[2]; a.w_in = (const float*)d_in[3]; a.w_uq = (const float*)d_in[4]; a.w_ukv = (const float*)d_in[5];
    a.w_o = (const float*)d_in[6]; a.norm_g = (const float*)d_in[7]; a.q_norm_g = (const float*)d_in[8]; a.kv_norm_g = (const float*)d_in[9]; a.lam_q1 = (const float*)d_in[10]; a.lam_k1 = (const float*)d_in[11];
    a.lam_q2 = (const float*)d_in[12]; a.lam_k2 = (const float*)d_in[13]; a.subln_g = (const float*)d_in[14]; a.w_ple = (const float*)d_in[15]; a.w_pg = (const float*)d_in[16]; a.final_g = (const float*)d_in[17];
    a.out = (float*)d_out; a.ws = (unsigned char*)d_ws;
#ifdef MULTI_LAUNCH
    k_phase<0, 7><<<grid, 512, LDS_BYTES, stream>>>(a, 0);
    for (int L = 0; L < DEPTH; ++L) {
        k_phase<1, 7><<<grid, 512, LDS_BYTES, stream>>>(a, L); k_phase<2, 1><<<grid, 512, LDS_BYTES, stream>>>(a, L); k_phase<2, 8><<<grid, 512, LDS_BYTES, stream>>>(a, L); k_phase<2, 2><<<grid, 512, LDS_BYTES, stream>>>(a, L); k_phase<2, 4><<<grid, 512, LDS_BYTES, stream>>>(a, L); k_phase<3, 7><<<grid, 512, LDS_BYTES, stream>>>(a, L);
        k_phase<4, 7><<<grid, 512, LDS_BYTES, stream>>>(a, L); k_phase<5, 7><<<grid, 512, LDS_BYTES, stream>>>(a, L);
    }
    k_phase<6, 7><<<grid, 512, LDS_BYTES, stream>>>(a, 0);
#else
    void* args[] = {&a};
    hipError_t e = hipLaunchCooperativeKernel((const void*)hybrid_fwd, dim3(grid), dim3(512), args, LDS_BYTES, stream);
    if (e != hipSuccess) fprintf(stderr, "cooperative launch failed: %s (grid %d)\n", hipGetErrorString(e), grid);
#endif
}
```

```cpp
#include <hip/hip_runtime.h>
#include <hip/hip_cooperative_groups.h>
#include <cstdio>
#include <cstdint>
namespace cg = cooperative_groups;

constexpr int NBATCH = 4, SEQ = 4096, TOK = NBATCH * SEQ, DM = 2048, DEPTH = 4, PLE = 256;
constexpr int DIN = 7176, NIN = 7168;
constexpr int NUQ = 1152, NUQP = 1280, KUQ = 384;
constexpr int NUKV = 1536, KUKV = 256;
constexpr int NTAB = 56;
constexpr float EPS = 1e-6f, LOG2E = 1.4426950408889634f;
constexpr float SC_A = 0.07216878364870322f * LOG2E;
constexpr float SC_B = 0.08838834764831845f * LOG2E;
constexpr float SC_C = 0.125f * LOG2E;

constexpr size_t al256(size_t x) { return (x + 255) & ~(size_t)255; }
constexpr size_t WS_CTRL = 0;
constexpr int CW_BAR = 4096, CTRL_WORDS = 8192;
constexpr size_t WS_SSQH = 65536;
constexpr size_t WS_SSQQ = WS_SSQH + (size_t)TOK * 32 * 4;
constexpr size_t WS_SSQKV = WS_SSQQ + (size_t)TOK * 12 * 4;
constexpr size_t WS_ZERO_END = WS_SSQKV + (size_t)TOK * 8 * 4;
constexpr size_t WS_TAB = al256(WS_ZERO_END);
constexpr size_t WS_WIN = al256(WS_TAB + (size_t)TOK * NTAB * 8);
constexpr size_t WS_WUQ = al256(WS_WIN + (size_t)DEPTH * NIN * DM * 2);
constexpr size_t WS_WUKV = al256(WS_WUQ + (size_t)DEPTH * NUQP * KUQ * 2);
constexpr size_t WS_WO = al256(WS_WUKV + (size_t)DEPTH * NUKV * KUKV * 2);
constexpr size_t WS_WPG = al256(WS_WO + (size_t)DEPTH * DM * DM * 2);
constexpr size_t WS_WPLE = al256(WS_WPG + (size_t)DEPTH * DM * DM * 2);
constexpr size_t WS_PB = al256(WS_WPLE + (size_t)DEPTH * DM * PLE * 2);
constexpr size_t WS_HB = al256(WS_PB + (size_t)DEPTH * TOK * PLE * 2);
constexpr size_t WS_HB2 = al256(WS_HB + (size_t)TOK * DM * 2);
constexpr size_t WS_PLEO = al256(WS_HB2 + (size_t)TOK * DM * 2);
constexpr size_t WS_CQ = al256(WS_PLEO + (size_t)TOK * DM * 2);
constexpr size_t WS_CKV = al256(WS_CQ + (size_t)TOK * 384 * 2);
constexpr size_t WS_KROPE = al256(WS_CKV + (size_t)TOK * 256 * 2);
constexpr size_t WS_KIDX = al256(WS_KROPE + (size_t)TOK * 64 * 2);
constexpr size_t WS_GATE = al256(WS_KIDX + (size_t)TOK * 64 * 2);
constexpr size_t WS_QKB = al256(WS_GATE + (size_t)TOK * DM * 2);
constexpr size_t WS_VBC = al256(WS_QKB + (size_t)TOK * 1280 * 2);
constexpr size_t WS_QKC = al256(WS_VBC + (size_t)TOK * 1280 * 2);
constexpr size_t WS_QI = al256(WS_QKC + (size_t)TOK * 1280 * 2);
constexpr size_t WS_WIDX = al256(WS_QI + (size_t)TOK * 512 * 2);
constexpr size_t WS_QMLA = al256(WS_WIDX + (size_t)TOK * 8 * 4);
constexpr size_t WS_KMLA = al256(WS_QMLA + (size_t)TOK * 1152 * 2);
constexpr size_t WS_VMLA = al256(WS_KMLA + (size_t)TOK * 768 * 2);
constexpr size_t WS_MASK = al256(WS_VMLA + (size_t)TOK * 768 * 2);
constexpr size_t WS_W8T = al256(WS_MASK + (size_t)TOK * 64 * 8);
constexpr size_t WS_SCR = al256(WS_W8T + (size_t)DEPTH * 16 * DM * 2);
constexpr size_t SCR_PER_BLOCK = 512 * 1024;
constexpr size_t WS_END = WS_SCR;
static_assert(WS_END <= (size_t)940572672, "workspace map exceeds 4 x largest tensor");

constexpr int LDS_MAIN = 131072, LDS_BYTES = LDS_MAIN + 1024;
#define LAS __attribute__((address_space(3)))
#ifndef REP_A2
#define REP_A2 1
#endif
#ifndef REP_SEL
#define REP_SEL 1
#endif
#ifndef REP_A01
#define REP_A01 1
#endif
#ifndef REP_G1
#define REP_G1 1
#endif
#ifndef REP_P0
#define REP_P0 1
#endif
#ifndef REP_SYNC
#define REP_SYNC 1
#endif

constexpr int LDS_WTAB = LDS_MAIN + 64;
__device__ __forceinline__ int opaque_tid() {
    const unsigned hw = __builtin_amdgcn_s_getreg((5 << 11) | 4) & 63u;
    const int w = __builtin_amdgcn_readfirstlane(*(volatile LAS int*)(uintptr_t)(LDS_WTAB + hw * 4));
    unsigned z = 0u; asm volatile("" : "+v"(z));
    const int lane = (int)__builtin_amdgcn_mbcnt_hi(~0u, __builtin_amdgcn_mbcnt_lo(~0u, z));
    return (w << 6) | lane;
}

namespace pg8 {
#define PG8_LAS __attribute__((address_space(3)))
typedef unsigned short bf16_t;
typedef short bf16x8 __attribute__((ext_vector_type(8)));
typedef float f32x4 __attribute__((ext_vector_type(4)));
typedef unsigned u32x4 __attribute__((ext_vector_type(4)));
constexpr int BM = 256, BK = 64, HALF = 128, HTB = HALF * BK * 2  , STAGE_BYTES = 8 * HTB, NXCD = 8, WGM = 8;

__host__ __device__ __forceinline__ int lds_byte(int r, int c) { const int st = (r >> 4) * 2 + (c >> 5), rr = r & 15, cc = c & 31, ob = rr * 64 + cc * 2; return st * 1024 + (ob ^ (((ob >> 9) & 1) << 5)); }
__host__ __device__ __forceinline__ void stage_rc(int b, int& R, int& C) { const int st = b / 1024, sb = b % 1024, swz = sb ^ (((sb >> 9) & 1) << 5); R = (st >> 1) * 16 + swz / 64; C = (st & 1) * 32 + (swz % 64) / 2; }
__host__ __device__ __forceinline__ int perm32(int rho) { const int n = rho >> 4, i = rho & 15; return 8 * (i >> 2) + 4 * n + (i & 3); }

struct Unit { int pm, pn; };
struct Gemm { const bf16_t* A; const bf16_t* Bt; int M, N, K; };

struct StaticOrder {
    int nM, nN, nwg, G, c;
    __host__ __device__ void init(int M, int N, int G_, int c_) { nM = M / BM; nN = N / BM; nwg = nM * nN; G = G_; c = c_; }
    __host__ __device__ bool next(int i, Unit& u) const {
        const long L = (long)i * G + c; if (L >= nwg) return false;
        int wgid = (int)L; { const int q = nwg / NXCD, r = nwg % NXCD, xcd = wgid % NXCD, off = wgid / NXCD; wgid = (xcd < r ? xcd * (q + 1) : r * (q + 1) + (xcd - r) * q) + off; }
        const int nig = WGM * nN, gid = wgid / nig, fm = gid * WGM, gsz = (nM - fm) < WGM ? (nM - fm) : WGM;
        u.pm = fm + ((wgid % nig) % gsz); u.pn = (wgid % nig) / gsz; return true;
    }
    __device__ __forceinline__ void a_ready(const Unit&) const {}
    __device__ __forceinline__ void done(const Unit&) const {}
};

__device__ __forceinline__ unsigned cvt_pk_bf16(float lo, float hi) { unsigned r; asm volatile("v_cvt_pk_bf16_f32 %0, %1, %2" : "=v"(r) : "v"(lo), "v"(hi)); return r; }
typedef float f32x2 __attribute__((ext_vector_type(2)));
typedef float2 tab_t;
__device__ __forceinline__ void rope8(float (&v)[8], const tab_t* tp) {
    const f32x4 t0 = *(const f32x4*)tp, t1 = *(const f32x4*)(tp + 2);
    const float c[4] = {t0[0], t0[2], t1[0], t1[2]}, s[4] = {t0[1], t0[3], t1[1], t1[3]};
#pragma unroll
    for (int j = 0; j < 4; ++j) { const float a = v[2 * j], b = v[2 * j + 1]; v[2 * j] = a * c[j] - b * s[j]; v[2 * j + 1] = b * c[j] + a * s[j]; }
}
__device__ __forceinline__ void store8(bf16_t* p, const float (&v)[8]) {
    u32x4 w; w.x = cvt_pk_bf16(v[0], v[1]); w.y = cvt_pk_bf16(v[2], v[3]); w.z = cvt_pk_bf16(v[4], v[5]); w.w = cvt_pk_bf16(v[6], v[7]);
    *(u32x4*)p = w;
}
template <int N4> __device__ __forceinline__ float sum_parts(const float* p) {
    f32x4 a = *(const f32x4*)p;
#pragma unroll
    for (int i = 1; i < N4; ++i) a += *(const f32x4*)(p + 4 * i);
    return (a[0] + a[1]) + (a[2] + a[3]);
}
__device__ __forceinline__ float silu_f(float x) { return x * __builtin_amdgcn_rcpf(1.0f + __builtin_amdgcn_exp2f(-x * 1.4426950408889634f)); }
__device__ __forceinline__ float sigmoid_f(float x) { return __builtin_amdgcn_rcpf(1.0f + __builtin_amdgcn_exp2f(-x * 1.4426950408889634f)); }

struct EpiIn {
    static constexpr bool PERM = true, AFTER_DRAIN = false;
    const float* ssq_h; float* ssq_q; float* ssq_kv;
    bf16_t *CQ, *CKV, *KROPE, *KIDX, *GATE, *QKB, *VBC, *QKC, *QI; const tab_t* TAB;
    __device__ __forceinline__ void operator()(const f32x4 (&acc)[2][2][4][2], const Unit& u, int wr, int wc, int fr, int fq) const {
        { const int t_ = opaque_tid(), w_ = __builtin_amdgcn_readfirstlane(t_ >> 6), l_ = t_ & 63; wr = w_ >> 2; wc = w_ & 3; fr = l_ & 15; fq = l_ >> 4; }
        const int pn = u.pn, row0 = u.pm * BM + wr * 64 + fr;
        bf16_t* dst[2]; int ld[2], tab[2], act[2], sld[2]; float sc[2]; float* ssq[2];
#pragma unroll
        for (int bj = 0; bj < 2; ++bj) {
            const int cc = bj * HALF + wc * 32 + fq * 8, n = pn * BM + cc;
            bf16_t* d = nullptr; int l = 0, col = 0, tb = -1, ac = 0, sl = 0; float s = 1.f; float* sq = nullptr;
            if (pn == 0) { d = CQ; l = 384; col = n; sq = ssq_q + bj * 4 + wc; sl = 12; }
            else if (pn == 1) {
                if (cc < 128) { d = CQ; l = 384; col = 256 + cc; sq = ssq_q + 8 + wc; sl = 12; }
                else if (cc < 192) { d = KROPE; l = 64; col = cc - 128; tb = (cc - 128) >> 1; }
                else { d = KIDX; l = 64; col = cc - 192; if (col < 16) tb = 48 + (col >> 1); }
            }
            else if (pn == 2) { d = CKV; l = 256; col = cc; sq = ssq_kv + bj * 4 + wc; sl = 8; }
            else if (pn < 11) { d = GATE; l = 2048; col = n - 768; ac = 1; }
            else if (pn < 16) { const int j = n - 2816; d = QKB; l = 1280; col = j; const int dd = j & 127; if (dd < 32) tb = 32 + (dd >> 1); if (j < 640) s = SC_B; }
            else if (pn < 21) { d = VBC; l = 1280; col = n - 4096; }
            else if (pn < 26) { const int j = n - 5376; d = QKC; l = 1280; col = j; const int dd = j & 63; if (dd < 16) tb = 48 + (dd >> 1); if (j < 640) s = SC_C; }
            else { const int j = n - 6656; d = QI; l = 512; col = j; const int dd = j & 63; if (dd < 16) tb = 48 + (dd >> 1); }
            dst[bj] = d + col; ld[bj] = l; tab[bj] = tb; act[bj] = ac; sld[bj] = sl; sc[bj] = s; ssq[bj] = sq;
        }
#pragma unroll
        for (int ai = 0; ai < 2; ++ai)
#pragma unroll
            for (int m = 0; m < 4; ++m) {
                const int row = row0 + ai * HALF + m * 16;
                const float r = __builtin_amdgcn_rsqf(sum_parts<8>(ssq_h + (size_t)row * 32) * (1.0f / 2048.0f) + 1e-6f);
#pragma unroll
                for (int bj = 0; bj < 2; ++bj) {
                    float v[8];
#pragma unroll
                    for (int e = 0; e < 4; ++e) { v[e] = acc[ai][bj][m][0][e] * r; v[4 + e] = acc[ai][bj][m][1][e] * r; }
                    if (tab[bj] >= 0) rope8(v, TAB + (size_t)row * NTAB + tab[bj]);
                    if (act[bj]) {
#pragma unroll
                        for (int e = 0; e < 8; ++e) v[e] = silu_f(v[e]);
                    }
#pragma unroll
                    for (int e = 0; e < 8; ++e) v[e] *= sc[bj];
                    if (ssq[bj]) { float s = 0.f;
#pragma unroll
                        for (int e = 0; e < 8; ++e) s += v[e] * v[e];
                        s += __shfl_xor(s, 16); s += __shfl_xor(s, 32);
                        if (fq == 0) ssq[bj][(size_t)row * sld[bj]] = s; }
                    store8(dst[bj] + (size_t)row * ld[bj], v);
                    asm volatile("" ::: "memory");
                }
            }
    }
};
struct EpiPlain {
    static constexpr bool PERM = true, AFTER_DRAIN = false;
    bf16_t* O; int ldc;
    __device__ __forceinline__ void operator()(const f32x4 (&acc)[2][2][4][2], const Unit& u, int wr, int wc, int fr, int fq) const {
        { const int t_ = opaque_tid(), w_ = __builtin_amdgcn_readfirstlane(t_ >> 6), l_ = t_ & 63; wr = w_ >> 2; wc = w_ & 3; fr = l_ & 15; fq = l_ >> 4; }
        const int row0 = u.pm * BM + wr * 64 + fr;
#pragma unroll
        for (int bj = 0; bj < 2; ++bj) { const int col = u.pn * BM + bj * HALF + wc * 32 + fq * 8;
#pragma unroll
            for (int ai = 0; ai < 2; ++ai)
#pragma unroll
                for (int m = 0; m < 4; ++m) { const int row = row0 + ai * HALF + m * 16; float v[8];
#pragma unroll
                    for (int e = 0; e < 4; ++e) { v[e] = acc[ai][bj][m][0][e]; v[4 + e] = acc[ai][bj][m][1][e]; }
                    store8(O + (size_t)row * ldc + col, v); } }
    }
};
struct EpiUq {
    static constexpr bool PERM = true, AFTER_DRAIN = false;
    const float* ssq; bf16_t* Q;
    __device__ __forceinline__ void operator()(const f32x4 (&acc)[2][2][4][2], const Unit& u, int wr, int wc, int fr, int fq) const {
        { const int t_ = opaque_tid(), w_ = __builtin_amdgcn_readfirstlane(t_ >> 6), l_ = t_ & 63; wr = w_ >> 2; wc = w_ & 3; fr = l_ & 15; fq = l_ >> 4; }
        const int row0 = u.pm * BM + wr * 64 + fr;
#pragma unroll
        for (int bj = 0; bj < 2; ++bj) { const int n = u.pn * BM + bj * HALF + wc * 32 + fq * 8;
            if (n < NUQ) {
#pragma unroll
            for (int ai = 0; ai < 2; ++ai)
#pragma unroll
                for (int m = 0; m < 4; ++m) { const int row = row0 + ai * HALF + m * 16;
                    const float r = __builtin_amdgcn_rsqf(sum_parts<3>(ssq + (size_t)row * 12) * (1.0f / 384.0f) + 1e-6f) * SC_A; float v[8];
#pragma unroll
                    for (int e = 0; e < 4; ++e) { v[e] = acc[ai][bj][m][0][e] * r; v[4 + e] = acc[ai][bj][m][1][e] * r; }
                    store8(Q + (size_t)row * NUQ + n, v); asm volatile("" ::: "memory"); } } }
    }
};
struct EpiUkv {
    static constexpr bool PERM = true, AFTER_DRAIN = false;
    const float* ssq; bf16_t* Kd; bf16_t* Vd;
    __device__ __forceinline__ void operator()(const f32x4 (&acc)[2][2][4][2], const Unit& u, int wr, int wc, int fr, int fq) const {
        { const int t_ = opaque_tid(), w_ = __builtin_amdgcn_readfirstlane(t_ >> 6), l_ = t_ & 63; wr = w_ >> 2; wc = w_ & 3; fr = l_ & 15; fq = l_ >> 4; }
        const int row0 = u.pm * BM + wr * 64 + fr;
        bf16_t* dst[2];
#pragma unroll
        for (int bj = 0; bj < 2; ++bj) { const int n = u.pn * BM + bj * HALF + wc * 32 + fq * 8; const int hd = n >> 8, d = n & 255; dst[bj] = (d < 128) ? (Kd + hd * 128 + d) : (Vd + hd * 128 + d - 128); }
#pragma unroll
        for (int ai = 0; ai < 2; ++ai)
#pragma unroll
            for (int m = 0; m < 4; ++m) { const int row = row0 + ai * HALF + m * 16;
                const float r = __builtin_amdgcn_rsqf(sum_parts<2>(ssq + (size_t)row * 8) * (1.0f / 256.0f) + 1e-6f);
#pragma unroll
                for (int bj = 0; bj < 2; ++bj) { float v[8];
#pragma unroll
                    for (int e = 0; e < 4; ++e) { v[e] = acc[ai][bj][m][0][e] * r; v[4 + e] = acc[ai][bj][m][1][e] * r; }
                    store8(dst[bj] + (size_t)row * 768, v); }
                asm volatile("" ::: "memory"); }
    }
};
struct EpiWo {
    static constexpr bool PERM = true, AFTER_DRAIN = false;
    const bf16_t* HBi; bf16_t* HBo;
    __device__ __forceinline__ void operator()(const f32x4 (&acc)[2][2][4][2], const Unit& u, int wr, int wc, int fr, int fq) const {
        { const int t_ = opaque_tid(), w_ = __builtin_amdgcn_readfirstlane(t_ >> 6), l_ = t_ & 63; wr = w_ >> 2; wc = w_ & 3; fr = l_ & 15; fq = l_ >> 4; }
        const int row0 = u.pm * BM + wr * 64 + fr;
#pragma unroll
        for (int bj = 0; bj < 2; ++bj) { const int col = u.pn * BM + bj * HALF + wc * 32 + fq * 8;
            u32x4 hw[2][4];
#pragma unroll
            for (int ai = 0; ai < 2; ++ai)
#pragma unroll
                for (int m = 0; m < 4; ++m) hw[ai][m] = *(const u32x4*)(HBi + (size_t)(row0 + ai * HALF + m * 16) * DM + col);
            asm volatile("" ::: "memory");
#pragma unroll
            for (int ai = 0; ai < 2; ++ai)
#pragma unroll
                for (int m = 0; m < 4; ++m) { const size_t off = (size_t)(row0 + ai * HALF + m * 16) * DM + col; float v[8];
#pragma unroll
                    for (int e2 = 0; e2 < 4; ++e2) { const unsigned g = hw[ai][m][e2];
                        const float a0 = (e2 < 2) ? acc[ai][bj][m][0][2 * e2] : acc[ai][bj][m][1][2 * e2 - 4], a1 = (e2 < 2) ? acc[ai][bj][m][0][2 * e2 + 1] : acc[ai][bj][m][1][2 * e2 - 3];
                        v[2 * e2] = __uint_as_float(g << 16) + a0; v[2 * e2 + 1] = __uint_as_float(g & 0xffff0000u) + a1; }
                    store8(HBo + off, v); }
            asm volatile("" ::: "memory"); }
    }
};
struct EpiPg {
    static constexpr bool PERM = true, AFTER_DRAIN = false;
    bf16_t* HBo; const bf16_t* P; float* ssq; const bf16_t* HBi;
    __device__ __forceinline__ void operator()(const f32x4 (&acc)[2][2][4][2], const Unit& u, int wr, int wc, int fr, int fq) const {
        { const int t_ = opaque_tid(), w_ = __builtin_amdgcn_readfirstlane(t_ >> 6), l_ = t_ & 63; wr = w_ >> 2; wc = w_ & 3; fr = l_ & 15; fq = l_ >> 4; }
        const int row0 = u.pm * BM + wr * 64 + fr;
#pragma unroll
        for (int ai = 0; ai < 2; ++ai) {
            float s[4] = {0.f, 0.f, 0.f, 0.f};
#pragma unroll
            for (int bj = 0; bj < 2; ++bj) { const int col = u.pn * BM + bj * HALF + wc * 32 + fq * 8;
                u32x4 hw[4], pw[4];
#pragma unroll
                for (int m = 0; m < 4; ++m) { const size_t off = (size_t)(row0 + ai * HALF + m * 16) * DM + col; hw[m] = *(const u32x4*)(HBi + off); pw[m] = *(const u32x4*)(P + off); }
                asm volatile("" ::: "memory");
#pragma unroll
                for (int m = 0; m < 4; ++m) { const size_t off = (size_t)(row0 + ai * HALF + m * 16) * DM + col; float v[8];
#pragma unroll
                    for (int e = 0; e < 4; ++e) {
                        const unsigned w = pw[m][e]; const float p0 = __uint_as_float(w << 16), p1 = __uint_as_float(w & 0xffff0000u);
                        const unsigned g = hw[m][e]; const float b0 = __uint_as_float(g << 16), b1 = __uint_as_float(g & 0xffff0000u);
                        const float a0 = (e < 2) ? acc[ai][bj][m][0][2 * e] : acc[ai][bj][m][1][2 * e - 4], a1 = (e < 2) ? acc[ai][bj][m][0][2 * e + 1] : acc[ai][bj][m][1][2 * e - 3];
                        v[2 * e] = b0 + p0 * sigmoid_f(a0); v[2 * e + 1] = b1 + p1 * sigmoid_f(a1); }
#pragma unroll
                    for (int e = 0; e < 8; ++e) s[m] += v[e] * v[e];
                    store8(HBo + off, v); }
                asm volatile("" ::: "memory"); }
#pragma unroll
            for (int m = 0; m < 4; ++m) { float t = s[m]; t += __shfl_xor(t, 16); t += __shfl_xor(t, 32);
                if (fq == 0) ssq[(size_t)(row0 + ai * HALF + m * 16) * 32 + u.pn * 4 + wc] = t; }
        }
    }
};
template <class Epi, class Sched, bool ALIGN_EPI = false, bool SP2 = false>
__device__ __forceinline__ void gemm_phase(PG8_LAS unsigned char* lds, const Gemm g, const Sched& S, const Epi& E) {
    const int tid = opaque_tid(), wid = __builtin_amdgcn_readfirstlane(tid >> 6), lane = tid & 63, wr = wid >> 2, wc = wid & 3, fr = lane & 15, fq = lane >> 4;
    const int K = g.K, nt = K / BK;
    unsigned voffA[2], voffB[2];
#pragma unroll
    for (int i = 0; i < 2; ++i) { int R, C; stage_rc(tid * 16 + i * 8192, R, C); const int Rb = Epi::PERM ? ((R & ~31) + perm32(R & 31)) : R;
        voffA[i] = (unsigned)(R * K + C) * 2u; voffB[i] = (unsigned)(Rb * K + C) * 2u; }
    const size_t kstep = (size_t)(BK * 2);
    const size_t hstep = (size_t)HALF * K * 2;
    const size_t tstep = 2 * hstep;
    const unsigned ldsw = (unsigned)wid * 1024u;
    const int aoff = lds_byte(wr * 64 + fr, fq * 8), boff = lds_byte(wc * 32 + fr, fq * 8);
#define PG8_SA(b, h) (((b) * 2 + (h)) * HTB)
#define PG8_SB(b, h) ((4 + (b) * 2 + (h)) * HTB)
#define PG8_STAGE(bufoff, gbase, voff) do { _Pragma("unroll") for (int _i = 0; _i < 2; ++_i) \
        __builtin_amdgcn_global_load_lds((const unsigned*)((const char*)(gbase) + (voff)[_i]), (PG8_LAS unsigned*)(lds + (bufoff) + ldsw + _i * 8192), 16, 0, 0); } while (0)
#define PG8_LDA(dst, b, h) do { _Pragma("unroll") for (int m = 0; m < 4; ++m) _Pragma("unroll") for (int k = 0; k < 2; ++k) dst[m][k] = *(const PG8_LAS bf16x8*)(lds + PG8_SA(b, h) + aoff + m * 2048 + k * 1024); } while (0)
#define PG8_LDB(dst, b, h) do { _Pragma("unroll") for (int n = 0; n < 2; ++n) _Pragma("unroll") for (int k = 0; k < 2; ++k) dst[n][k] = *(const PG8_LAS bf16x8*)(lds + PG8_SB(b, h) + boff + n * 2048 + k * 1024); } while (0)
#define PG8_MMA(ai, bj, At, Bt) do { __builtin_amdgcn_s_setprio(1); _Pragma("unroll") for (int m = 0; m < 4; ++m) _Pragma("unroll") for (int n = 0; n < 2; ++n) _Pragma("unroll") for (int k = 0; k < 2; ++k) \
        acc[ai][bj][m][n] = __builtin_amdgcn_mfma_f32_16x16x32_bf16(Bt[n][k], At[m][k], acc[ai][bj][m][n], 0, 0, 0); __builtin_amdgcn_s_setprio(0); } while (0)
#define PG8_WAIT_V(n) asm volatile("s_waitcnt vmcnt(" #n ")" ::: "memory")
#define PG8_WAIT_L(n) asm volatile("s_waitcnt lgkmcnt(" #n ")" ::: "memory")
#define PG8_BAR __builtin_amdgcn_s_barrier()
#define PG8_SCHED __builtin_amdgcn_sched_barrier(0)
    Unit cur, nxt; int ui = 0;
    if (!S.next(0, cur)) return;
    f32x4 acc[2][2][4][2];
#pragma unroll
    for (int a = 0; a < 2; ++a)
#pragma unroll
        for (int b = 0; b < 2; ++b)
#pragma unroll
            for (int m = 0; m < 4; ++m)
#pragma unroll
                for (int n = 0; n < 2; ++n) acc[a][b][m][n] = (f32x4){0.f, 0.f, 0.f, 0.f};
    bf16x8 At[4][2], B0[2][2], B1[2][2];
    const char* cA = (const char*)g.A + (size_t)cur.pm * tstep; const char* cB = (const char*)g.Bt + (size_t)cur.pn * tstep;
    S.a_ready(cur);
    if constexpr (SP2) {
        PG8_STAGE(PG8_SB(0, 0), cB, voffB); PG8_STAGE(PG8_SB(0, 1), cB + hstep, voffB); PG8_STAGE(PG8_SA(0, 0), cA, voffA); PG8_STAGE(PG8_SA(0, 1), cA + hstep, voffA);
        if (wr == 1) PG8_BAR;
        PG8_WAIT_V(2); PG8_BAR;
        PG8_STAGE(PG8_SB(1, 0), cB + kstep, voffB); PG8_STAGE(PG8_SA(1, 0), cA + kstep, voffA); PG8_STAGE(PG8_SB(1, 1), cB + hstep + kstep, voffB);
        PG8_WAIT_V(6); PG8_BAR;
    } else {
        PG8_STAGE(PG8_SB(0, 0), cB, voffB); PG8_STAGE(PG8_SA(0, 0), cA, voffA); PG8_STAGE(PG8_SB(0, 1), cB + hstep, voffB); PG8_STAGE(PG8_SA(0, 1), cA + hstep, voffA);
        if (wr == 1) PG8_BAR;
        PG8_WAIT_V(4); PG8_BAR;
        PG8_STAGE(PG8_SB(1, 0), cB + kstep, voffB); PG8_STAGE(PG8_SA(1, 0), cA + kstep, voffA); PG8_STAGE(PG8_SB(1, 1), cB + hstep + kstep, voffB);
        PG8_WAIT_V(6); PG8_BAR;
    }
    for (;;) {
        const bool has_next = S.next(ui + 1, nxt);
        const char* nA = has_next ? (const char*)g.A + (size_t)nxt.pm * tstep : cA; const char* nB = has_next ? (const char*)g.Bt + (size_t)nxt.pn * tstep : cB;
        for (int t = 0; t < nt; t += 2) {
            const bool last = (t == nt - 2);
            const char* a1 = cA + (size_t)(t + 1) * kstep;
            const char* a2 = last ? nA : cA + (size_t)(t + 2) * kstep; const char* b2 = last ? nB : cB + (size_t)(t + 2) * kstep;
            const char* a3 = a2 + kstep; const char* b3 = b2 + kstep;
            if (last && has_next) S.a_ready(nxt);
            if constexpr (SP2) {
            PG8_LDB(B0, 0, 0); PG8_LDB(B1, 0, 1); PG8_SCHED; PG8_LDA(At, 0, 0); PG8_STAGE(PG8_SA(1, 1), a1 + hstep, voffA);
            PG8_WAIT_V(8); PG8_WAIT_L(0); PG8_BAR; PG8_MMA(0, 0, At, B0); PG8_MMA(0, 1, At, B1); PG8_BAR; PG8_SCHED;
            PG8_LDA(At, 0, 1); PG8_STAGE(PG8_SB(0, 0), b2, voffB); PG8_STAGE(PG8_SB(0, 1), b2 + hstep, voffB); PG8_STAGE(PG8_SA(0, 0), a2, voffA);
            PG8_WAIT_V(8); PG8_WAIT_L(0); PG8_BAR; PG8_MMA(1, 0, At, B0); PG8_MMA(1, 1, At, B1); PG8_BAR; PG8_SCHED;
            PG8_LDB(B0, 1, 0); PG8_LDB(B1, 1, 1); PG8_SCHED; PG8_LDA(At, 1, 0); PG8_STAGE(PG8_SA(0, 1), a2 + hstep, voffA);
            PG8_WAIT_V(8); PG8_WAIT_L(0); PG8_BAR; PG8_MMA(0, 0, At, B0); PG8_MMA(0, 1, At, B1); PG8_BAR; PG8_SCHED;
            PG8_LDA(At, 1, 1); PG8_STAGE(PG8_SB(1, 0), b3, voffB); PG8_STAGE(PG8_SB(1, 1), b3 + hstep, voffB); PG8_STAGE(PG8_SA(1, 0), a3, voffA);
            PG8_WAIT_V(8); PG8_WAIT_L(0); PG8_BAR; PG8_MMA(1, 0, At, B0); PG8_MMA(1, 1, At, B1); PG8_BAR; PG8_SCHED;
            } else {
            PG8_LDB(B0, 0, 0); PG8_SCHED; PG8_LDA(At, 0, 0); PG8_STAGE(PG8_SA(1, 1), a1 + hstep, voffA);
            PG8_WAIT_L(8); PG8_BAR; PG8_WAIT_L(0); PG8_MMA(0, 0, At, B0); PG8_BAR; PG8_SCHED;
            PG8_LDB(B1, 0, 1); PG8_STAGE(PG8_SB(0, 0), b2, voffB);
            PG8_BAR; PG8_WAIT_L(0); PG8_MMA(0, 1, At, B1); PG8_BAR;
            PG8_LDA(At, 0, 1); PG8_STAGE(PG8_SA(0, 0), a2, voffA);
            PG8_BAR; PG8_WAIT_L(0); PG8_MMA(1, 0, At, B0); PG8_BAR; PG8_SCHED;
            PG8_STAGE(PG8_SB(0, 1), b2 + hstep, voffB);
            PG8_WAIT_V(6); PG8_BAR; PG8_MMA(1, 1, At, B1); PG8_BAR;
            PG8_LDB(B0, 1, 0); PG8_SCHED; PG8_LDA(At, 1, 0); PG8_STAGE(PG8_SA(0, 1), a2 + hstep, voffA);
            PG8_WAIT_L(8); PG8_BAR; PG8_WAIT_L(0); PG8_MMA(0, 0, At, B0); PG8_BAR; PG8_SCHED;
            PG8_LDB(B1, 1, 1); PG8_STAGE(PG8_SB(1, 0), b3, voffB);
            PG8_BAR; PG8_WAIT_L(0); PG8_MMA(0, 1, At, B1); PG8_BAR;
            PG8_LDA(At, 1, 1); PG8_STAGE(PG8_SA(1, 0), a3, voffA);
            PG8_BAR; PG8_WAIT_L(0); PG8_MMA(1, 0, At, B0); PG8_BAR; PG8_SCHED;
            PG8_STAGE(PG8_SB(1, 1), b3 + hstep, voffB);
            PG8_WAIT_V(6); PG8_BAR; PG8_MMA(1, 1, At, B1); PG8_BAR;
            }
        }
        if constexpr (ALIGN_EPI) { if (wr == 0) PG8_BAR; }
        if constexpr (!Epi::AFTER_DRAIN) { E(acc, cur, wr, wc, fr, fq); S.done(cur); }
        if (!has_next) break;
#pragma unroll
        for (int a = 0; a < 2; ++a)
#pragma unroll
            for (int b = 0; b < 2; ++b)
#pragma unroll
                for (int m = 0; m < 4; ++m)
#pragma unroll
                    for (int n = 0; n < 2; ++n) acc[a][b][m][n] = (f32x4){0.f, 0.f, 0.f, 0.f};
        cur = nxt; cA = nA; cB = nB; ++ui;
        if constexpr (ALIGN_EPI) { if (wr == 1) PG8_BAR; }
    }
    PG8_WAIT_V(0);
    if constexpr (!ALIGN_EPI) { if (wr == 0) PG8_BAR; }
    PG8_BAR;
    if constexpr (Epi::AFTER_DRAIN) { E.fused(acc, cur, wr, wc, fr, fq, lds, wid, lane); S.done(cur); }
#undef PG8_SA
#undef PG8_SB
#undef PG8_STAGE
#undef PG8_LDA
#undef PG8_LDB
#undef PG8_MMA
#undef PG8_WAIT_V
#undef PG8_WAIT_L
#undef PG8_BAR
#undef PG8_SCHED
}
}
namespace att {
typedef short bf16x8 __attribute__((ext_vector_type(8)));
typedef short s16x4 __attribute__((ext_vector_type(4)));
typedef float f32x16 __attribute__((ext_vector_type(16)));
typedef float f32x4 __attribute__((ext_vector_type(4)));
typedef unsigned u32x4 __attribute__((ext_vector_type(4)));
typedef unsigned u32x2 __attribute__((ext_vector_type(2)));
typedef unsigned short bf16_t;
typedef LAS const char* lptr;
constexpr int ST_K = 0, ST_V = 16384, ST_K64 = 32768, ST_BYTES = 40960;

__device__ __forceinline__ unsigned offb(unsigned row, unsigned ch) { return 256u * row + 16u * (ch ^ (((row & 3) << 2) | ((row >> 2) & 3))); }
__device__ __forceinline__ unsigned off64(unsigned row, unsigned ch) { return 128u * row + 16u * (ch ^ ((row >> 1) & 7)); }
__device__ __forceinline__ unsigned cvtpk(float lo, float hi) { unsigned r; asm("v_cvt_pk_bf16_f32 %0, %1, %2" : "=v"(r) : "v"(lo), "v"(hi)); return r; }
__device__ __forceinline__ s16x4 vtr(lptr p) { typedef short v4i16_t __attribute__((ext_vector_type(4))); return __builtin_bit_cast(s16x4, __builtin_amdgcn_ds_read_tr16_b64_v4i16((LAS v4i16_t*)p)); }
__device__ __forceinline__ float max_x32(float v) { const unsigned u = __float_as_uint(v); auto r = __builtin_amdgcn_permlane32_swap(u, u, false, false); return fmaxf(__uint_as_float(r[0]), __uint_as_float(r[1])); }
__device__ __forceinline__ float sum_x32(float v) { const unsigned u = __float_as_uint(v); auto r = __builtin_amdgcn_permlane32_swap(u, u, false, false); return __uint_as_float(r[0]) + __uint_as_float(r[1]); }
__device__ __forceinline__ float bf_lo(unsigned w) { return __uint_as_float(w << 16); }
__device__ __forceinline__ float bf_hi(unsigned w) { return __uint_as_float(w & 0xffff0000u); }

template <bool MASKED>
__device__ __forceinline__ void softmax_tile(f32x16& s0, f32x16& s1, float& m, float& l, float& alpha, unsigned mlo, unsigned mhi, bf16x8 (&pk)[4]) {
    const float NEG = -1e30f;
    if (MASKED) {
#pragma unroll
        for (int r = 0; r < 16; ++r) { const int bit = (r & 3) + 8 * (r >> 2); if (!((mlo >> bit) & 1u)) s0[r] = NEG; if (!((mhi >> bit) & 1u)) s1[r] = NEG; }
    }
    float mx = fmaxf(s0[0], s1[0]);
#pragma unroll
    for (int r = 1; r < 16; ++r) mx = fmaxf(mx, fmaxf(s0[r], s1[r]));
    mx = max_x32(mx);
    const float mn = fmaxf(m, mx);
    alpha = __builtin_amdgcn_exp2f(m - mn); m = mn;
    float sum = 0.f;
#pragma unroll
    for (int r = 0; r < 16; ++r) {
        float p0 = __builtin_amdgcn_exp2f(s0[r] - mn), p1 = __builtin_amdgcn_exp2f(s1[r] - mn);
        if (MASKED) { if (s0[r] <= -1e29f) p0 = 0.f; if (s1[r] <= -1e29f) p1 = 0.f; }
        s0[r] = p0; s1[r] = p1; sum += p0 + p1;
    }
    l = l * alpha + sum;
#pragma unroll
    for (int k2 = 0; k2 < 2; ++k2) {
        u32x4 a, b;
        a.x = cvtpk(s0[8 * k2 + 0], s0[8 * k2 + 1]); a.y = cvtpk(s0[8 * k2 + 2], s0[8 * k2 + 3]); a.z = cvtpk(s0[8 * k2 + 4], s0[8 * k2 + 5]); a.w = cvtpk(s0[8 * k2 + 6], s0[8 * k2 + 7]);
        b.x = cvtpk(s1[8 * k2 + 0], s1[8 * k2 + 1]); b.y = cvtpk(s1[8 * k2 + 2], s1[8 * k2 + 3]); b.z = cvtpk(s1[8 * k2 + 4], s1[8 * k2 + 5]); b.w = cvtpk(s1[8 * k2 + 6], s1[8 * k2 + 7]);
        pk[k2] = __builtin_bit_cast(bf16x8, a); pk[2 + k2] = __builtin_bit_cast(bf16x8, b);
    }
}

struct AttnPtrs {
    const bf16_t* Q; int ldq;
    const bf16_t* K; int ldk;
    const bf16_t* K64;
    const bf16_t* V; int ldv;
    const bf16_t* G; bf16_t* Go;
    const unsigned long long* MASK;
    float lam, c_out; const float* subg;
};

template <int MODE>
__device__ __forceinline__ void attn_unit(LAS char* lds, const AttnPtrs& A, int b, int qb) {
    constexpr int NQ = (MODE == 0) ? 12 : (MODE == 1 ? 8 : 4);
    const int tid = opaque_tid(), lane = tid & 63, r32 = lane & 31, hi = lane >> 5, wid = __builtin_amdgcn_readfirstlane(tid >> 6);
    const int strm = (MODE == 2) ? (wid & 1) : 0;
    const size_t rowbase = (size_t)b * SEQ; const int q0 = (MODE == 2) ? qb * 128 + (wid >> 1) * 32 : qb * 256 + wid * 32; const int cw = q0 >> 6, NT = (MODE == 2) ? 2 * qb + 2 : 4 * qb + 4;
    const size_t qrow = rowbase + q0 + r32;
    bf16x8 qf[NQ];
#pragma unroll
    for (int s = 0; s < NQ; ++s) qf[s] = *(const bf16x8*)(A.Q + qrow * A.ldq + 64 * strm + 16 * s + 8 * hi);
    if constexpr (MODE == 0) {
#pragma unroll
        for (int s = 0; s < 4; ++s) {
            const u32x4 w = __builtin_bit_cast(u32x4, qf[8 + s]);
            const f32x4 t0 = *(const f32x4*)(A.subg + (qrow * 56 + 8 * s + 4 * hi) * 2), t1 = *(const f32x4*)(A.subg + (qrow * 56 + 8 * s + 4 * hi) * 2 + 4);
            u32x4 o;
            { const float a = bf_lo(w.x), b = bf_hi(w.x); o.x = cvtpk(a * t0[0] - b * t0[1], b * t0[0] + a * t0[1]); }
            { const float a = bf_lo(w.y), b = bf_hi(w.y); o.y = cvtpk(a * t0[2] - b * t0[3], b * t0[2] + a * t0[3]); }
            { const float a = bf_lo(w.z), b = bf_hi(w.z); o.z = cvtpk(a * t1[0] - b * t1[1], b * t1[0] + a * t1[1]); }
            { const float a = bf_lo(w.w), b = bf_hi(w.w); o.w = cvtpk(a * t1[2] - b * t1[3], b * t1[2] + a * t1[3]); }
            qf[8 + s] = __builtin_bit_cast(bf16x8, o);
        }
    }
#pragma unroll
    for (int s = 0; s < NQ; ++s) asm volatile("" :: "v"(qf[s]));
    const bf16_t* ksrc[2]; const bf16_t* vsrc[2];
#pragma unroll
    for (int i = 0; i < 2; ++i) { const unsigned row = 4u * (2 * wid + i) + (lane >> 4), ch = (lane & 15) ^ (((row & 3) << 2) | ((row >> 2) & 3));
        ksrc[i] = A.K + (rowbase + row) * A.ldk + ch * 8; vsrc[i] = A.V + (rowbase + row) * A.ldv + ch * 8; }
    const bf16_t* k64src = nullptr;
    if constexpr (MODE == 0) { const unsigned row = 8u * wid + (lane >> 3), ch = (lane & 7) ^ ((row >> 1) & 7); k64src = A.K64 + (rowbase + row) * 64 + ch * 8; }
    const unsigned fK = ((r32 & 3) << 2) | ((r32 >> 2) & 3);
    const unsigned g64 = (r32 >> 1) & 7;
    const int q4 = (lane & 15) >> 2, p4 = lane & 3, blk = (lane >> 4) & 1;
    unsigned vrow[2], vlow[2];
#pragma unroll
    for (int t = 0; t < 2; ++t) { vrow[t] = 4 * hi + 8 * t + q4; vlow[t] = (unsigned)((2 * blk + (p4 >> 1)) ^ ((hi + 2 * t) & 3)); }
#define DMA16(src_, ldsoff_) __builtin_amdgcn_global_load_lds((const unsigned*)(src_), (LAS unsigned*)(lds + (ldsoff_)), 16, 0, 0)
#define STAGE(t_, st_) do { const size_t o_ = (size_t)(t_) * 64; const int sb_ = (st_) * ST_BYTES + wid * 2048; \
        DMA16(ksrc[0] + o_ * A.ldk, sb_ + ST_K); DMA16(ksrc[1] + o_ * A.ldk, sb_ + ST_K + 1024); \
        DMA16(vsrc[0] + o_ * A.ldv, sb_ + ST_V); DMA16(vsrc[1] + o_ * A.ldv, sb_ + ST_V + 1024); \
        if constexpr (MODE == 0) DMA16(k64src + o_ * 64, (st_) * ST_BYTES + ST_K64 + wid * 1024); } while (0)
    f32x16 o1[4];
#pragma unroll
    for (int c = 0; c < 4; ++c) o1[c] = f32x16{};
    float m1 = -1e30f, l1 = 0.f;
    unsigned long long mw_next = 0ull;
    if constexpr (MODE == 1) { mw_next = A.MASK[qrow * 64]; asm volatile("" : "+v"(mw_next)); }
    bf16x8 pk[4]; float a1 = 1.f;
#define KFRAG(S_, K0_, K1_) do { if ((S_) < 8) { const unsigned ad_ = 256u * r32 + 16u * ((unsigned)(2 * (S_) + hi + 8 * strm) ^ fK); \
                K0_ = *(const LAS bf16x8*)(sb + ST_K + ad_); K1_ = *(const LAS bf16x8*)(sb + ST_K + ad_ + 8192); } \
            else { const unsigned ad_ = 128u * r32 + 16u * ((unsigned)(2 * ((S_) - 8) + hi) ^ g64); \
                K0_ = *(const LAS bf16x8*)(sb + ST_K64 + ad_); K1_ = *(const LAS bf16x8*)(sb + ST_K64 + ad_ + 4096); } } while (0)
#define QK_PASS(NS_) do { _Pragma("unroll") for (int b_ = 0; b_ < (NS_); b_ += 4) { bf16x8 ka[4], kb[4]; \
                _Pragma("unroll") for (int i_ = 0; i_ < 4; ++i_) KFRAG(b_ + i_, ka[i_], kb[i_]); \
                __builtin_amdgcn_sched_barrier(0); \
                _Pragma("unroll") for (int i_ = 0; i_ < 4; ++i_) { s0 = __builtin_amdgcn_mfma_f32_32x32x16_bf16(ka[i_], qf[b_ + i_], s0, 0, 0, 0); s1 = __builtin_amdgcn_mfma_f32_32x32x16_bf16(kb[i_], qf[b_ + i_], s1, 0, 0, 0); } \
                __builtin_amdgcn_sched_barrier(0); } } while (0)
#define VTR_ASM(DST_, ADDR_) asm volatile("ds_read_b64_tr_b16 %0, %1" : "=v"(DST_) : "v"(ADDR_))
#define PV_PASS(SB_) do { if (__any(a1 != 1.f)) { _Pragma("unroll") for (int c = 0; c < 4; ++c) o1[c] *= a1; } \
            const unsigned vb_ = (unsigned)(uintptr_t)(SB_) + ST_V + 8u * (p4 & 1); \
            _Pragma("unroll") for (int b_ = 0; b_ < 16; b_ += 8) { s16x4 vl[8], vh[8]; \
                _Pragma("unroll") for (int i_ = 0; i_ < 8; ++i_) { const int c_ = (b_ + i_) >> 2, ks_ = (b_ + i_) & 3; const unsigned chi_ = (unsigned)((c_ ^ q4) << 2); \
                    VTR_ASM(vl[i_], vb_ + 256u * (16 * ks_ + vrow[0]) + 16u * (chi_ | vlow[0])); \
                    VTR_ASM(vh[i_], vb_ + 256u * (16 * ks_ + vrow[1]) + 16u * (chi_ | vlow[1])); } \
                asm volatile("s_waitcnt lgkmcnt(0)" ::: "memory"); __builtin_amdgcn_sched_barrier(0); \
                _Pragma("unroll") for (int i_ = 0; i_ < 8; ++i_) { const s16x4 lo = vl[i_], h4 = vh[i_]; \
                    const bf16x8 vf = (bf16x8){lo[0], lo[1], lo[2], lo[3], h4[0], h4[1], h4[2], h4[3]}; \
                    o1[(b_ + i_) >> 2] = __builtin_amdgcn_mfma_f32_32x32x16_bf16(vf, pk[(b_ + i_) & 3], o1[(b_ + i_) >> 2], 0, 0, 0); } \
                __builtin_amdgcn_sched_barrier(0); } } while (0)
#define WAIT_TILE(all_) do { if (all_) asm volatile("s_waitcnt vmcnt(0) lgkmcnt(0)" ::: "memory"); \
        else if constexpr (MODE == 0) asm volatile("s_waitcnt vmcnt(5) lgkmcnt(0)" ::: "memory"); else asm volatile("s_waitcnt vmcnt(4) lgkmcnt(0)" ::: "memory"); \
        __builtin_amdgcn_s_barrier(); asm volatile("" ::: "memory"); } while (0)
    STAGE(0, 0); STAGE(1, 1);
    WAIT_TILE(false);
    int st_cur = 0, st_nn = 2;
    for (int t = 0; t < NT; ++t) {
        unsigned mlo = 0, mhi = 0;
        if constexpr (MODE == 1) { if (t <= cw) {
            const unsigned long long w = mw_next; mlo = (unsigned)w >> (4 * hi); mhi = (unsigned)(w >> 32) >> (4 * hi);
            asm volatile("" : "+v"(mlo), "+v"(mhi));
            if (t < cw) { const unsigned long long* mp_ = A.MASK + qrow * 64 + t + 1; asm volatile("global_load_dwordx2 %0, %1, off" : "+v"(mw_next) : "v"(mp_) : "memory"); } } }
        const bool more2 = (t + 2 < NT);
        if (more2) STAGE(t + 2, st_nn);
        if (t <= cw) {
            const lptr sb = (lptr)(lds + st_cur * ST_BYTES);
            f32x16 s0 = f32x16{}, s1 = f32x16{};
            QK_PASS(NQ);
            if constexpr (MODE == 1) softmax_tile<true>(s0, s1, m1, l1, a1, mlo, mhi, pk); else softmax_tile<false>(s0, s1, m1, l1, a1, 0, 0, pk);
            PV_PASS(sb);
        }
        WAIT_TILE(!more2);
        st_cur = (st_cur == 2) ? 0 : st_cur + 1; st_nn = (st_nn == 2) ? 0 : st_nn + 1;
    }
#undef WAIT_TILE
#undef PV_PASS
#undef QK_PASS
#undef VTR_ASM
#undef KFRAG
    l1 = sum_x32(l1); const float i1 = 1.0f / l1;
    float rstd = 1.f;
    if constexpr (MODE == 2) {
        LAS float* xb = (LAS float*)lds + (wid >> 1) * 4096 + lane;
        if (strm == 1) { const float i2 = A.lam * i1;
#pragma unroll
            for (int c = 0; c < 4; ++c)
#pragma unroll
                for (int r = 0; r < 16; ++r) xb[(c * 16 + r) * 64] = o1[c][r] * i2; }
        __syncthreads();
        if (strm == 0) { float ss = 0.f;
#pragma unroll
            for (int c = 0; c < 4; ++c)
#pragma unroll
                for (int r = 0; r < 16; ++r) { const float v = o1[c][r] * i1 - xb[(c * 16 + r) * 64]; o1[c][r] = v; ss += v * v; }
            ss = sum_x32(ss); rstd = __builtin_amdgcn_rsqf(ss * (1.0f / 128.0f) + 1e-6f) * A.c_out; }
        __syncthreads();
        if (strm == 1) return;
    }
    const bf16_t* grow = A.G + qrow * 2048; bf16_t* orow = A.Go + qrow * 2048;
#pragma unroll
    for (int c = 0; c < 4; ++c)
#pragma unroll
        for (int rr = 0; rr < 4; ++rr) {
            const int dv = 32 * c + 8 * rr + 4 * hi;
            const u32x2 g = *(const u32x2*)(grow + dv);
            float v[4];
#pragma unroll
            for (int e = 0; e < 4; ++e) v[e] = o1[c][4 * rr + e];
            if (MODE == 2) { const f32x4 sg = *(const f32x4*)(A.subg + dv);
#pragma unroll
                for (int e = 0; e < 4; ++e) v[e] *= rstd * sg[e]; }
            else {
#pragma unroll
                for (int e = 0; e < 4; ++e) v[e] *= i1; }
            u32x2 w; w.x = cvtpk(v[0] * bf_lo(g.x), v[1] * bf_hi(g.x)); w.y = cvtpk(v[2] * bf_lo(g.y), v[3] * bf_hi(g.y));
            *(u32x2*)(orow + dv) = w;
        }
}
#undef STAGE
#undef DMA16
}
namespace sel {
using att::bf16x8; using att::u32x4; using att::bf16_t; using att::f32x4;
constexpr int L_QI = 0, L_HIST = 16384, L_PART = 32768 + 64,     L_PREF = L_PART + 2048, L_KREM = L_PREF + 64, L_NEQ = L_KREM + 64, L_FLAG = L_NEQ + 64, L_W = L_FLAG + 64;
__device__ __forceinline__ unsigned fkey(float f) { const unsigned u = __float_as_uint(f); return (u & 0x80000000u) ? ~u : (u | 0x80000000u); }

__device__ __forceinline__ void scan_hist(LAS char* lds, int shiftbits) {
    LAS unsigned* hist = (LAS unsigned*)(lds + L_HIST); LAS unsigned* part = (LAS unsigned*)(lds + L_PART);
    LAS unsigned* pref = (LAS unsigned*)(lds + L_PREF); LAS unsigned* kremS = (LAS unsigned*)(lds + L_KREM); LAS unsigned* neqS = (LAS unsigned*)(lds + L_NEQ);
    const int tid = opaque_tid(), q = tid & 15, g = tid >> 4;
    unsigned hv[8]; unsigned s = 0;
#pragma unroll
    for (int j = 0; j < 8; ++j) { hv[j] = hist[(8 * g + j) * 16 + q]; s += hv[j]; }
    const unsigned krem = kremS[q];
    part[g * 16 + q] = s;
    __syncthreads();
    unsigned above = 0;
#pragma unroll
    for (int gg = 0; gg < 32; ++gg) { const unsigned pv = part[gg * 16 + q]; above += (gg > g) ? pv : 0u; }
    if (above < krem && krem <= above + s) {
        unsigned cum = above; int bsel = 8 * g; unsigned hsel = 0; bool done = false;
#pragma unroll
        for (int j = 7; j >= 0; --j) { if (!done) { if (cum + hv[j] >= krem) { bsel = 8 * g + j; hsel = hv[j]; done = true; } else cum += hv[j]; } }
        pref[q] = (pref[q] << shiftbits) | (unsigned)bsel; kremS[q] = krem - cum; neqS[q] = hsel;
    }
    __syncthreads();
}
#define SEL_HADD(idx_) __hip_atomic_fetch_add(&hist[(idx_)], 1u, __ATOMIC_RELAXED, __HIP_MEMORY_SCOPE_WORKGROUP)

__device__ __forceinline__ void sel_unit(LAS char* lds, int b, int u, const bf16_t* QI, const bf16_t* KIDX, const float* WIDX, unsigned long long* MASK) {
    const int tid = opaque_tid(), lane = tid & 63, q16 = lane & 15, kg = lane >> 4, wid = __builtin_amdgcn_readfirstlane(tid >> 6);
    const size_t rowbase = (size_t)b * SEQ; const int q0 = u * 16, c = q0 >> 6;
    const size_t gq = rowbase + q0 + q16;
    if (c <= 3) {
        unsigned ones = 0xffffffffu; asm volatile("" : "+v"(ones));
        for (int i = tid; i < 16 * (c + 1); i += 512) { unsigned* mp = (unsigned*)(MASK + (rowbase + q0 + (i & 15)) * 64 + (i >> 4)); mp[0] = ones; mp[1] = ones; }
        return;
    }
    LAS unsigned* hist = (LAS unsigned*)(lds + L_HIST);
    LAS unsigned* pref = (LAS unsigned*)(lds + L_PREF); LAS unsigned* kremS = (LAS unsigned*)(lds + L_KREM); LAS unsigned* neqS = (LAS unsigned*)(lds + L_NEQ);
#pragma unroll
    for (int i = 0; i < 2; ++i) { const int id = tid + 512 * i, row = id >> 6, ch = id & 63;
        *(LAS u32x4*)(lds + L_QI + row * 1024 + ((ch ^ (row & 15)) << 4)) = *(const u32x4*)(QI + (rowbase + q0 + row) * 512 + ch * 8); }
    for (int i = tid; i < 4096; i += 512) hist[i] = 0u;
    if (tid < 16) { pref[tid] = 0u; kremS[tid] = 256u; }
    if (tid < 128) ((LAS float*)(lds + L_W))[tid] = WIDX[(rowbase + q0 + (tid & 15)) * 8 + (tid >> 4)];
    const LAS float* wl = (const LAS float*)(lds + L_W) + q16;
    __syncthreads();
    const int nj = (c - wid + 8) >> 3;
    u32x4 sc[8][4];
#pragma unroll
    for (int j = 0; j < 8; ++j) {
        if (j < nj) {
            int t = wid + 8 * j; asm volatile("" : "+s"(t));
#pragma unroll
            for (int kh = 0; kh < 2; ++kh) {
            bf16x8 kf[2][2];
#pragma unroll
            for (int kb = 0; kb < 2; ++kb)
#pragma unroll
                for (int ks = 0; ks < 2; ++ks) kf[kb][ks] = *(const bf16x8*)(KIDX + (rowbase + 64 * t + 32 * kh + 16 * kb + q16) * 64 + 32 * ks + 8 * kg);
#pragma unroll
            for (int kb = 0; kb < 2; ++kb) {
                f32x4 s = (f32x4){0.f, 0.f, 0.f, 0.f};
#pragma unroll
                for (int hh = 0; hh < 8; ++hh) {
                    f32x4 a = (f32x4){0.f, 0.f, 0.f, 0.f};
#pragma unroll
                    for (int ks = 0; ks < 2; ++ks) {
                        const bf16x8 qv = *(const LAS bf16x8*)(lds + L_QI + q16 * 1024 + (((hh * 8 + 4 * ks + kg) ^ q16) << 4));
                        a = __builtin_amdgcn_mfma_f32_16x16x32_bf16(kf[kb][ks], qv, a, 0, 0, 0);
                    }
                    const float wh = wl[hh * 16];
#pragma unroll
                    for (int i = 0; i < 4; ++i) s[i] += wh * fmaxf(a[i], 0.f);
                }
                u32x4 kk; kk.x = fkey(s[0]); kk.y = fkey(s[1]); kk.z = fkey(s[2]); kk.w = fkey(s[3]);
                sc[j][2 * kh + kb] = kk;
#pragma unroll
                for (int i = 0; i < 4; ++i) SEL_HADD((kk[i] >> 24) * 16 + q16);
                __builtin_amdgcn_sched_barrier(0);
            }
            asm volatile("" ::: "memory");
            }
        }
    }
#define SEL_TILE(j_) (wid + 8 * (j_))
    __syncthreads();
    scan_hist(lds, 8);
#pragma unroll 1
    for (int pass = 1; pass < 4; ++pass) {
        const int shift = 24 - 8 * pass;
        { const int t_ = opaque_tid(); for (int i = t_; i < 4096; i += 512) hist[i] = 0u; }
        __syncthreads();
        const unsigned pf = pref[q16];
        unsigned zz = 0u; asm volatile("" : "+v"(zz));
#pragma unroll
        for (int j = 0; j < 8; ++j) if (j < nj) {
#pragma unroll
            for (int kb = 0; kb < 4; ++kb)
#pragma unroll
                for (int i = 0; i < 4; ++i) { const unsigned k = sc[j][kb][i] | zz; SEL_HADD((((k >> (shift + 8)) == pf) ? ((k >> shift) & 255u) * 16 : 4096u) + q16); __builtin_amdgcn_sched_barrier(0); }
        }
        __syncthreads();
        scan_hist(lds, 8);
    }
    const unsigned kstar = pref[q16]; unsigned vthr = 0u;
    {
        LAS unsigned* flag = (LAS unsigned*)(lds + L_FLAG);
        const int t3 = opaque_tid();
        if (t3 == 0) flag[0] = 0u;
        __syncthreads();
        if (t3 < 16 && neqS[t3] > kremS[t3]) flag[0] = 1u;
        __syncthreads();
        if (flag[0]) {
            if (t3 < 16) pref[t3] = 0u;
#pragma unroll 1
            for (int pass = 0; pass < 2; ++pass) {
                { const int t_ = opaque_tid(); for (int i = t_; i < 4096; i += 512) hist[i] = 0u; }
                __syncthreads();
                const unsigned pf = pref[q16];
                unsigned zz = 0u; asm volatile("" : "+v"(zz));
#pragma unroll
                for (int j = 0; j < 8; ++j) if (j < nj) {
#pragma unroll
                    for (int kb = 0; kb < 4; ++kb)
#pragma unroll
                        for (int i = 0; i < 4; ++i) { const unsigned k = sc[j][kb][i] | zz;
                            const unsigned v = (4095u - (unsigned)(64 * SEL_TILE(j) + 16 * kb + 4 * (int)(__builtin_amdgcn_mbcnt_hi(~0u, __builtin_amdgcn_mbcnt_lo(~0u, zz)) >> 4) + i)) | zz;
                            SEL_HADD(((k == kstar && (pass == 0 || (v >> 4) == pf)) ? (pass == 0 ? (v >> 4) : (v & 15u)) * 16 : 4096u) + q16); __builtin_amdgcn_sched_barrier(0); }
                }
                __syncthreads();
                scan_hist(lds, pass == 0 ? 8 : 4);
            }
            vthr = pref[q16];
        }
    }
    const int tid2 = opaque_tid(), kg2 = (tid2 & 63) >> 4; const size_t gq2 = rowbase + q0 + (tid2 & 15);
#pragma unroll
    for (int j = 0; j < 8; ++j) if (j < nj) {
        const int t = SEL_TILE(j);
        unsigned lo = 0u, hi = 0u;
#pragma unroll
        for (int kb = 0; kb < 4; ++kb)
#pragma unroll
            for (int i = 0; i < 4; ++i) { const unsigned k = sc[j][kb][i]; const unsigned kin = 16 * kb + 4 * kg2 + i;
                const unsigned v = 4095u - (unsigned)(64 * t + kin);
                const unsigned s = ((k > kstar) || (k == kstar && v >= vthr)) ? 1u : 0u;
                if (kb < 2) lo |= s << kin; else hi |= s << (kin - 32); __builtin_amdgcn_sched_barrier(0); }
        { auto r = __builtin_amdgcn_permlane32_swap(lo, lo, false, false); lo = r[0] | r[1]; r = __builtin_amdgcn_permlane16_swap(lo, lo, false, false); lo = r[0] | r[1];
          r = __builtin_amdgcn_permlane32_swap(hi, hi, false, false); hi = r[0] | r[1]; r = __builtin_amdgcn_permlane16_swap(hi, hi, false, false); hi = r[0] | r[1]; }
        if (kg2 == 0) MASK[gq2 * 64 + t] = ((unsigned long long)hi << 32) | lo;
    }
    __syncthreads();
}
#undef SEL_HADD
#undef SEL_TILE
}
typedef unsigned short bf16;
typedef unsigned v4u __attribute__((ext_vector_type(4)));
typedef float f32x4 __attribute__((ext_vector_type(4)));
__device__ __forceinline__ unsigned f2bf(float f) { unsigned u = __builtin_bit_cast(unsigned, f); return (u + 0x7fffu + ((u >> 16) & 1u)) >> 16; }
__device__ __forceinline__ unsigned pk2(float lo, float hi) { return f2bf(lo) | (f2bf(hi) << 16); }
__device__ __forceinline__ float wave_sum(float v) {
#pragma unroll
    for (int o = 1; o < 64; o <<= 1) v += __shfl_xor(v, o);
    return v;
}
__device__ __forceinline__ int pairperm(int d, int nrot) { return d < nrot ? ((d & 1) ? (nrot / 2 + (d >> 1)) : (d >> 1)) : d; }
__device__ __forceinline__ int colmap_in(int n) {
    if (n < 384) return n;
    if (n < 448) return 640 + pairperm(n - 384, 64);
    if (n < 512) return 3904 + pairperm(n - 448, 16);
    if (n < 768) return 384 + (n - 512);
    if (n < 2816) { const int j = n - 768; return j < 768 ? 704 + j : (j < 1408 ? 3976 + (j - 768) : 6536 + (j - 1408)); }
    if (n < 4096) { const int j = n - 2816, w = j / 640, r = j % 640; return (w ? 2112 : 1472) + (r & ~127) + pairperm(r & 127, 32); }
    if (n < 5376) { const int j = n - 4096; return j < 640 ? 2752 + j : 5896 + (j - 640); }
    if (n < 6656) { const int j = n - 5376, w = j / 640, r = j % 640; return (w ? 5256 : 4616) + (r & ~63) + pairperm(r & 63, 16); }
    if (n < 7168) { const int j = n - 6656; return 3392 + (j & ~63) + pairperm(j & 63, 16); }
    return -1;
}
__device__ __forceinline__ int colmap_uq(int n) { if (n >= NUQ) return -1; const int hd = n / 192, d = n % 192; return hd * 192 + (d < 128 ? d : 128 + pairperm(d - 128, 64)); }
template <int MAP>
__device__ __forceinline__ void transpose_item(const float* W, int K, int Nsrc, int Ndst, bf16* WT, const float* gain, LAS float* scr, int item, int lane) {
    const int nblk = Ndst / 32, kb = item / nblk, nb = item % nblk, k0 = 64 * kb, n0 = 32 * nb;
    const int nn = n0 + (lane & 31); const int sc = MAP == 0 ? nn : (MAP == 1 ? colmap_in(nn) : colmap_uq(nn));
    float wv_[32];
#pragma unroll
    for (int i = 0; i < 32; ++i) { const int kk = 2 * i + (lane >> 5); wv_[i] = (sc >= 0) ? W[(size_t)(k0 + kk) * Nsrc + sc] : 0.f; }
#pragma unroll
    for (int i = 0; i < 32; ++i) { const int kk = 2 * i + (lane >> 5); float v = wv_[i]; if (gain) v *= gain[k0 + kk]; scr[kk * 33 + (lane & 31)] = v; }
    asm volatile("s_waitcnt lgkmcnt(0)" ::: "memory");
    const int c = lane & 7;
#pragma unroll
    for (int j = 0; j < 4; ++j) { const int n = (lane >> 3) + 8 * j; const LAS float* s = scr + (8 * c) * 33 + n;
        v4u o; o.x = pk2(s[0 * 33], s[1 * 33]); o.y = pk2(s[2 * 33], s[3 * 33]); o.z = pk2(s[4 * 33], s[5 * 33]); o.w = pk2(s[6 * 33], s[7 * 33]);
        *(v4u*)(WT + (size_t)(n0 + n) * K + k0 + 8 * c) = o; }
    asm volatile("s_waitcnt lgkmcnt(0)" ::: "memory");
}

struct Args {
    const float *x, *p; const int* pos; const float *w_in, *w_uq, *w_ukv, *w_o, *norm_g, *q_norm_g, *kv_norm_g, *lam_q1, *lam_k1, *lam_q2, *lam_k2, *subln_g, *w_ple, *w_pg, *final_g;
    float* out; unsigned char* ws;
};

__device__ __forceinline__ int fetch_item(unsigned* ctr, LAS unsigned* slot_unused) {
    unsigned sa = (unsigned)LDS_MAIN; asm volatile("" : "+v"(sa));
    LAS unsigned* slot = (LAS unsigned*)(uintptr_t)sa;
    __syncthreads();
    if (opaque_tid() == 0) *slot = atomicAdd(ctr, 1u);
    __syncthreads();
    return __builtin_amdgcn_readfirstlane((int)*slot);
}

typedef const __attribute__((address_space(4))) Args* argp_t;
#define OPQ_WS() argp_t ap = (argp_t)__builtin_amdgcn_kernarg_segment_ptr(); asm volatile("" : "+s"(ap)); unsigned char* ws = ap->ws
#define ctrl ((unsigned*)(ws + WS_CTRL))
#define ssqh ((float*)(ws + WS_SSQH))
#define ssqq ((float*)(ws + WS_SSQQ))
#define ssqkv ((float*)(ws + WS_SSQKV))
#define TAB ((pg8::tab_t*)(ws + WS_TAB))
#define WIN ((bf16*)(ws + WS_WIN))
#define WUQ ((bf16*)(ws + WS_WUQ))
#define WUKV ((bf16*)(ws + WS_WUKV))
#define WO ((bf16*)(ws + WS_WO))
#define WPG ((bf16*)(ws + WS_WPG))
#define WPLE ((bf16*)(ws + WS_WPLE))
#define PB ((bf16*)(ws + WS_PB))
#define HB ((bf16*)(ws + WS_HB))
#define HB2 ((bf16*)(ws + WS_HB2))
#define PLEO ((bf16*)(ws + WS_PLEO))
#define CQ ((bf16*)(ws + WS_CQ))
#define CKV ((bf16*)(ws + WS_CKV))
#define KROPE ((bf16*)(ws + WS_KROPE))
#define KIDX ((bf16*)(ws + WS_KIDX))
#define GATE ((bf16*)(ws + WS_GATE))
#define QKB ((bf16*)(ws + WS_QKB))
#define VBC ((bf16*)(ws + WS_VBC))
#define QKC ((bf16*)(ws + WS_QKC))
#define QI ((bf16*)(ws + WS_QI))
#define WIDX ((float*)(ws + WS_WIDX))
#define QMLA ((bf16*)(ws + WS_QMLA))
#define KMLA ((bf16*)(ws + WS_KMLA))
#define VMLA ((bf16*)(ws + WS_VMLA))
#define MASK ((unsigned long long*)(ws + WS_MASK))
#define W8T ((bf16*)(ws + WS_W8T))
#define SCR ((float*)(ws + WS_SCR + (size_t)bx * SCR_PER_BLOCK))

template <int PH, int SUB = 15>
__device__ __forceinline__ void run_phase(const int L) {
    extern __shared__ __attribute__((aligned(16))) unsigned char lds_raw[];
    LAS unsigned char* lds = (LAS unsigned char*)lds_raw;
    LAS unsigned* slot = (LAS unsigned*)(lds + LDS_MAIN);
    const int G = gridDim.x, bx = blockIdx.x;
    if constexpr (PH == 0) {
    for (int rep0 = 0; rep0 < REP_P0; ++rep0)
    {
        OPQ_WS();
        const int tid = opaque_tid(), lane = tid & 63, wave = __builtin_amdgcn_readfirstlane(tid >> 6);
        const int gt = bx * 512 + tid, NGT = G * 512, gw = bx * 8 + wave, NGW = G * 8;
        for (int i = gt; i < CTRL_WORDS; i += NGT) ctrl[i] = 0u;
        LAS float* scr = (LAS float*)(lds + wave * 8704);
        constexpr int I_IN = (DM / 64) * (NIN / 32), I_UQ = (KUQ / 64) * (NUQP / 32), I_UKV = (KUKV / 64) * (NUKV / 32), I_SQ = (DM / 64) * (DM / 32), I_PLE = (PLE / 64) * (DM / 32);
        constexpr int I_L = I_IN + I_UQ + I_UKV + 2 * I_SQ + I_PLE;
        for (int it = gw; it < DEPTH * I_L; it += NGW) {
            const int L = it / I_L; int r = it % I_L;
            if (r < I_IN) { transpose_item<1>(ap->w_in + (size_t)L * DM * DIN, DM, DIN, NIN, WIN + (size_t)L * NIN * DM, ap->norm_g + L * DM, scr, r, lane); continue; } r -= I_IN;
            if (r < I_UQ) { transpose_item<2>(ap->w_uq + (size_t)L * KUQ * NUQ, KUQ, NUQ, NUQP, WUQ + (size_t)L * NUQP * KUQ, ap->q_norm_g + L * KUQ, scr, r, lane); continue; } r -= I_UQ;
            if (r < I_UKV) { transpose_item<0>(ap->w_ukv + (size_t)L * KUKV * NUKV, KUKV, NUKV, NUKV, WUKV + (size_t)L * NUKV * KUKV, ap->kv_norm_g + L * KUKV, scr, r, lane); continue; } r -= I_UKV;
            if (r < I_SQ) { transpose_item<0>(ap->w_o + (size_t)L * DM * DM, DM, DM, DM, WO + (size_t)L * DM * DM, nullptr, scr, r, lane); continue; } r -= I_SQ;
            if (r < I_SQ) { transpose_item<0>(ap->w_pg + (size_t)L * DM * DM, DM, DM, DM, WPG + (size_t)L * DM * DM, nullptr, scr, r, lane); continue; } r -= I_SQ;
            transpose_item<0>(ap->w_ple + (size_t)L * PLE * DM, PLE, DM, DM, WPLE + (size_t)L * DM * PLE, nullptr, scr, r, lane);
        }
        for (int i = gt; i < DEPTH * 16 * DM; i += NGT) { const int Lw = i / (16 * DM), c = (i / DM) & 15, k = i % DM;
            W8T[i] = (bf16)((c < 8) ? f2bf(ap->w_in[((size_t)Lw * DM + k) * DIN + 3968 + c] * ap->norm_g[Lw * DM + k]) : 0u); }
        { const int n8 = DEPTH * TOK * PLE / 8;
#pragma unroll 4
          for (int i = gt; i < n8; i += NGT) { const f32x4 v0 = *(const f32x4*)(ap->p + (size_t)i * 8), v1 = *(const f32x4*)(ap->p + (size_t)i * 8 + 4);
              v4u o; o.x = pk2(v0[0], v0[1]); o.y = pk2(v0[2], v0[3]); o.z = pk2(v1[0], v1[1]); o.w = pk2(v1[2], v1[3]); *(v4u*)(PB + (size_t)i * 8) = o; } }
        for (int m = gw; m < TOK; m += NGW) {
            const f32x4* xr = (const f32x4*)(ap->x + (size_t)m * DM) + lane; float s = 0.f;
            unsigned long long* o8 = (unsigned long long*)(HB + (size_t)m * DM) + lane;
#pragma unroll
            for (int j = 0; j < 8; ++j) { const f32x4 v = xr[64 * j]; s += (v[0] * v[0] + v[1] * v[1]) + (v[2] * v[2] + v[3] * v[3]);
                o8[64 * j] = (unsigned long long)pk2(v[0], v[1]) | ((unsigned long long)pk2(v[2], v[3]) << 32); }
            s = wave_sum(s); if (lane < 32) ssqh[(size_t)m * 32 + lane] = (lane == 0) ? s : 0.f;
        }
        for (int i = gt; i < TOK * NTAB; i += NGT) {
            const int t = i / NTAB, j = i % NTAB; int nrot, fi; if (j < 32) { nrot = 64; fi = j; } else if (j < 48) { nrot = 32; fi = j - 32; } else { nrot = 16; fi = j - 48; }
            const float e = (float)fi * (2.0f / (float)nrot); const float invf = 1.0f / powf(500000.0f, e);
            const float ang = (float)ap->pos[t] * invf; const double rev = (double)ang * 0.15915494309189535; const float fr = (float)(rev - floor(rev));
            TAB[i] = make_float2(__builtin_amdgcn_cosf(fr), __builtin_amdgcn_sinf(fr));
        }
    }

    }
    if constexpr (PH == 1) {
    for (int rep1 = 0; rep1 < REP_G1; ++rep1)
        {
            OPQ_WS();
            pg8::Gemm g{HB, WIN + (size_t)L * NIN * DM, TOK, NIN, DM}; pg8::StaticOrder S; S.init(TOK, NIN, G, bx);
            pg8::EpiIn E{ssqh, ssqq, ssqkv, CQ, CKV, KROPE, KIDX, GATE, QKB, VBC, QKC, QI, TAB};
#ifndef NO_G1
            pg8::gemm_phase<pg8::EpiIn, pg8::StaticOrder, true, true>(lds, g, S, E);
#endif
            pg8::Gemm g2{PB + (size_t)L * TOK * PLE, WPLE + (size_t)L * DM * PLE, TOK, DM, PLE}; pg8::StaticOrder S2; S2.init(TOK, DM, G, (bx + 64) % G);
            pg8::EpiPlain E2{PLEO, DM};
#ifndef NO_G1B
            pg8::gemm_phase<pg8::EpiPlain, pg8::StaticOrder, true, true>(lds, g2, S2, E2);
#endif
            {
                const int tid = opaque_tid(), lane = tid & 63, wave = __builtin_amdgcn_readfirstlane(tid >> 6);
                for (int grp = bx * 8 + wave; grp < TOK / 16; grp += G * 8) {
                    const bf16* pa = HB + (size_t)(grp * 16 + (lane & 15)) * DM + 8 * (lane >> 4);
                    const bf16* pb = W8T + ((size_t)L * 16 + (lane & 15)) * DM + 8 * (lane >> 4);
                    f32x4 acc = (f32x4){0.f, 0.f, 0.f, 0.f};
#pragma unroll 16
                    for (int s = 0; s < DM / 32; ++s) acc = __builtin_amdgcn_mfma_f32_16x16x32_bf16(*(const att::bf16x8*)(pa + 32 * s), *(const att::bf16x8*)(pb + 32 * s), acc, 0, 0, 0);
                    if ((lane & 15) < 8) {
#pragma unroll
                        for (int i = 0; i < 4; ++i) { const int row = grp * 16 + 4 * (lane >> 4) + i;
                            const float r = __builtin_amdgcn_rsqf(pg8::sum_parts<8>(ssqh + (size_t)row * 32) * (1.0f / 2048.0f) + 1e-6f);
                            WIDX[(size_t)row * 8 + (lane & 15)] = acc[i] * r; }
                    }
                }
            }
        }
    }
    if constexpr (PH == 2) {
        {
            OPQ_WS();
            if constexpr (SUB & 1) {
            { pg8::Gemm g{CQ, WUQ + (size_t)L * NUQP * KUQ, TOK, NUQP, KUQ}; pg8::StaticOrder S; S.init(TOK, NUQP, G, bx);
              pg8::EpiUq E{ssqq, QMLA};

#ifndef NO_G2
              pg8::gemm_phase<pg8::EpiUq, pg8::StaticOrder, true, false>(lds, g, S, E);
#endif
 }
            }
            if constexpr (SUB & 8) {
            { pg8::Gemm g{CKV, WUKV + (size_t)L * NUKV * KUKV, TOK, NUKV, KUKV}; pg8::StaticOrder S; S.init(TOK, NUKV, G, (bx + 64) % G);
              pg8::EpiUkv E{ssqkv, KMLA, VMLA};

#ifndef NO_G2B
              pg8::gemm_phase<pg8::EpiUkv, pg8::StaticOrder, true, true>(lds, g, S, E);
#endif
 }
            }
            if constexpr (SUB & 2) {
            float s1 = 0.f, s2 = 0.f;
            for (int i = 0; i < 64; ++i) { s1 += ap->lam_q1[L * 64 + i] * ap->lam_k1[L * 64 + i]; s2 += ap->lam_q2[L * 64 + i] * ap->lam_k2[L * 64 + i]; }
            const float lam_init = 0.8f - 0.6f * expf(-0.3f * (float)L); const float lam = expf(s1) - expf(s2) + lam_init;
            for (int rep = 0; rep < REP_A2; ++rep)
            { unsigned* ctr = ctrl + L * 32 + 0 + 4 * rep;
              for (;;) {
                const int it = fetch_item(ctr, slot);
                if (it >= 640) break;
                const int qb = 31 - it / 20, bh = it % 20, b = bh / 5, h = bh % 5;
                att::AttnPtrs A{QKC + 2 * h * 64, 1280, QKC + 640 + 2 * h * 64, 1280, nullptr, VBC + 640 + h * 128, 1280, GATE + 1408 + h * 128, GATE + 1408 + h * 128, nullptr, lam, 1.0f - lam_init, ap->subln_g + L * 128};
#ifndef NO_A2
                att::attn_unit<2>((LAS char*)lds, A, b, qb);
#endif
              } }
            }
            if constexpr (SUB & 4)
            for (int rep = 0; rep < REP_SEL; ++rep)
            { unsigned* ctr = ctrl + L * 32 + 1 + 4 * rep;
              for (;;) {
                const int j = fetch_item(ctr, slot);
                if (j >= 1024) break;
                const int u = 255 - j / 4, b = j % 4;
#ifndef NO_SEL
                sel::sel_unit((LAS char*)lds, b, u, QI, KIDX, WIDX, MASK);
#endif
              } }
        }
    }
    if constexpr (PH == 3) {
        {
            OPQ_WS();
            for (int rep = 0; rep < REP_A01; ++rep) {
            unsigned* ctr = ctrl + L * 32 + 2 + 4 * rep;
            for (;;) {
                const int it = fetch_item(ctr, slot);
                if (it >= 704) break;
                const int qb = 15 - it / 44, w = it % 44;
                if (w < 24) { const int b = w / 6, h = w % 6;
                    att::AttnPtrs A{QMLA + h * 192, NUQ, KMLA + h * 128, 768, KROPE, VMLA + h * 128, 768, GATE + h * 128, GATE + h * 128, nullptr, 0.f, 0.f, (const float*)TAB};
#ifndef NO_A0
                    att::attn_unit<0>((LAS char*)lds, A, b, qb);
#endif
                } else { const int w2 = w - 24, b = w2 / 5, h = w2 % 5;
                    att::AttnPtrs A{QKB + h * 128, 1280, QKB + 640 + h * 128, 1280, nullptr, VBC + h * 128, 1280, GATE + 768 + h * 128, GATE + 768 + h * 128, MASK, 0.f, 0.f, nullptr};
#ifndef NO_A1
                    att::attn_unit<1>((LAS char*)lds, A, b, qb);
#endif
                }
            }
            }
        }
    }
    if constexpr (PH == 4) {
        {
            OPQ_WS();
            pg8::Gemm g{GATE, WO + (size_t)L * DM * DM, TOK, DM, DM};     pg8::StaticOrder S; S.init(TOK, DM, G, bx);
            pg8::EpiWo E{HB, HB2};
#ifndef NO_G4
            pg8::gemm_phase<pg8::EpiWo, pg8::StaticOrder, true, true>(lds, g, S, E);
#endif
        }
    }
    if constexpr (PH == 5) {
        {
            OPQ_WS();
            pg8::Gemm g{HB2, WPG + (size_t)L * DM * DM, TOK, DM, DM}; pg8::StaticOrder S; S.init(TOK, DM, G, bx);
            pg8::EpiPg E{HB, PLEO, ssqh, HB2};
#ifndef NO_G5
            pg8::gemm_phase<pg8::EpiPg, pg8::StaticOrder, true, true>(lds, g, S, E);
#endif
        }
    }
    if constexpr (PH == 6) {
    {
        OPQ_WS();
        const int tid = opaque_tid();
        const int gt = bx * 512 + tid, NGT = G * 512; const float* ss = ssqh;
        for (int i = gt; i < TOK * DM / 4; i += NGT) { const int row = i / (DM / 4), c4 = i % (DM / 4);
            const float r = __builtin_amdgcn_rsqf(pg8::sum_parts<8>(ss + (size_t)row * 32) * (1.0f / 2048.0f) + 1e-6f); const f32x4 gv = *(const f32x4*)(ap->final_g + c4 * 4);
            const unsigned long long hw = *(const unsigned long long*)(HB + (size_t)i * 4); const unsigned w0 = (unsigned)hw, w1 = (unsigned)(hw >> 32);
            f32x4 v = (f32x4){__uint_as_float(w0 << 16), __uint_as_float(w0 & 0xffff0000u), __uint_as_float(w1 << 16), __uint_as_float(w1 & 0xffff0000u)}; v = v * r * gv; *(f32x4*)(ap->out + (size_t)i * 4) = v; }
    }
    }
}
__device__ __forceinline__ void init_wave_table() {
    extern __shared__ __attribute__((aligned(16))) unsigned char lds_raw[];
    const unsigned hw = __builtin_amdgcn_s_getreg((5 << 11) | 4) & 63u;
    if ((threadIdx.x & 63) == 0) { *(volatile LAS int*)(uintptr_t)(LDS_WTAB + hw * 4) = (int)(threadIdx.x >> 6); if (threadIdx.x == 0x7fffffff) lds_raw[0] = 0; }
    if (threadIdx.x == 0) { *(volatile LAS unsigned*)(uintptr_t)(LDS_MAIN + 16) = 0u; *(volatile LAS unsigned*)(uintptr_t)(LDS_MAIN + 20) = 0u; }
    __syncthreads();
}
#define RLX_AGENT __ATOMIC_RELAXED, __HIP_MEMORY_SCOPE_AGENT
#define XB_TMO      128
#define XB_XCNT(j)  (256  + 64 * (j))
#define XB_XSUB(j)  (1280 + 64 * (j))
#define XB_XGEN(j)  (2304 + 64 * (j))
#define XB_TOP      3328
#define XB_TOPGEN   3392
#define XCD_BAR_WORDS 3456
#define XB_SPIN_CAP (1u << 18)

__device__ __forceinline__ unsigned xb_ld(unsigned* p)              { return __hip_atomic_load(p, __ATOMIC_RELAXED, __HIP_MEMORY_SCOPE_AGENT); }
__device__ __forceinline__ unsigned xb_add(unsigned* p, unsigned v) { return __hip_atomic_fetch_add(p, v, __ATOMIC_RELAXED, __HIP_MEMORY_SCOPE_AGENT); }
__device__ __forceinline__ unsigned xb_xcc_id() { return (unsigned)__builtin_amdgcn_s_getreg((3 << 11) | 20) & 0xFu; }
#define XB_SPIN(cond, bar) do { unsigned _sp = 0; while (cond) { __builtin_amdgcn_s_sleep(1); \
    if ((++_sp & 255u) == 0u) { if (xb_ld(&(bar)[XB_TMO])) break; if (_sp > XB_SPIN_CAP) { atomicAdd(&(bar)[XB_TMO], 1u); break; } } } } while (0)

struct XcdBarrier {
    unsigned* bar; unsigned x;
    volatile LAS unsigned* st;
};

__device__ __forceinline__ XcdBarrier xcd_barrier_post(unsigned* bar, volatile LAS unsigned* st) {
    XcdBarrier b; b.bar = bar; b.x = xb_xcc_id(); b.st = st;
    if (opaque_tid() == 0) (void)xb_add(&bar[XB_XCNT(b.x)], 1u);
    return b;
}
__device__ __forceinline__ void xcd_barrier_complete(unsigned* bar, unsigned x, unsigned& nloc, unsigned& nx) {
    const unsigned G = gridDim.x * gridDim.y * gridDim.z;
    unsigned sum, cnt, mine, sp = 0u;
    for (;;) {
        sum = 0u; cnt = 0u; mine = 0u;
#pragma unroll
        for (unsigned j = 0; j < 16; ++j) { const unsigned c = xb_ld(&bar[XB_XCNT(j)]); sum += c; cnt += (c > 0u) ? 1u : 0u; mine = (j == x) ? c : mine; }
        if (sum == G) break;
        __builtin_amdgcn_s_sleep(1);
        if ((++sp & 255u) == 0u) { if (xb_ld(&bar[XB_TMO])) break; if (sp > XB_SPIN_CAP) { atomicAdd(&bar[XB_TMO], 1u); break; } }
    }
    nloc = mine > 0u ? mine : 1u; nx = cnt > 0u ? cnt : 1u;
}

__device__ __forceinline__ void xcd_barrier(const XcdBarrier& b) {
    asm volatile("s_waitcnt vmcnt(0)" ::: "memory");
    __syncthreads();
    if (opaque_tid() == 0) {
        unsigned* bar = b.bar;
        __builtin_amdgcn_s_waitcnt(0);
        unsigned nloc = b.st[0], nx = b.st[1];
        if (nloc == 0u) { xcd_barrier_complete(bar, b.x, nloc, nx); b.st[0] = nloc; b.st[1] = nx; }
        const unsigned old = xb_add(&bar[XB_XSUB(b.x)], 1u);
        const unsigned gen = old / nloc;
        if (old + 1u == (gen + 1u) * nloc) {
            __builtin_amdgcn_fence(__ATOMIC_RELEASE, "agent");
            asm volatile("s_waitcnt vmcnt(0)" ::: "memory");
            const unsigned og = xb_add(&bar[XB_TOP], 1u);
            const unsigned tg = og / nx;
            if (og + 1u == (tg + 1u) * nx) xb_add(&bar[XB_TOPGEN], 1u);
            else XB_SPIN(xb_ld(&bar[XB_TOPGEN]) == tg, bar);
            __builtin_amdgcn_fence(__ATOMIC_ACQUIRE, "agent");
            xb_add(&bar[XB_XGEN(b.x)], 1u);
            asm volatile("s_waitcnt vmcnt(0)" ::: "memory");
        } else {
            XB_SPIN(xb_ld(&bar[XB_XGEN(b.x)]) == gen, bar);
            __builtin_amdgcn_fence(__ATOMIC_ACQUIRE, "agent");
            asm volatile("s_waitcnt vmcnt(0)" ::: "memory");
        }
    }
    __syncthreads();
}

#ifdef MULTI_LAUNCH
template <int PH, int SUB> __global__ void __launch_bounds__(512, 2) k_phase(Args a_kernarg, int L) { init_wave_table(); run_phase<PH, SUB>(L); }
#else
__global__ void __launch_bounds__(512, 2) hybrid_fwd(Args a_kernarg) {
    cg::grid_group grid = cg::this_grid();
    init_wave_table();
    run_phase<0>(0);
    grid.sync();
#define XBAR_MAKE() argp_t apb = (argp_t)__builtin_amdgcn_kernarg_segment_ptr(); asm volatile("" : "+s"(apb)); unsigned* barw = (unsigned*)(apb->ws + WS_CTRL) + CW_BAR
    { XBAR_MAKE(); (void)xcd_barrier_post(barw, (volatile LAS unsigned*)(uintptr_t)(LDS_MAIN + 16)); }
#define GSYNC() do { XBAR_MAKE(); XcdBarrier xb_; xb_.bar = barw; xb_.x = xb_xcc_id(); xb_.st = (volatile LAS unsigned*)(uintptr_t)(LDS_MAIN + 16); for (int rs_ = 0; rs_ < REP_SYNC; ++rs_) xcd_barrier(xb_); } while (0)
    for (int L = 0; L < DEPTH; ++L) {
        run_phase<1>(L); GSYNC();
        run_phase<2>(L); GSYNC();
        run_phase<3>(L); GSYNC();
        run_phase<4>(L); GSYNC();
        run_phase<5>(L); GSYNC();
    }
    run_phase<6>(0);
}
#endif

extern "C" void kernel_launch(void* const* d_in, const int* in_sizes, int n_in, void* d_out, int out_size, void* d_ws, size_t ws_size, hipStream_t stream) {
    static int grid = 0;
    if (grid == 0) {
        if (n_in != 18 || out_size != TOK * DM || ws_size < WS_END) { fprintf(stderr, "kernel_launch: unexpected shapes (n_in %d out %d ws %zu need %zu)\n", n_in, out_size, ws_size, (size_t)WS_END); grid = -1; return; }
        int dev = 0, cus = 0;
        (void)hipGetDevice(&dev); (void)hipDeviceGetAttribute(&cus, hipDeviceAttributeMultiprocessorCount, dev);
#ifdef MULTI_LAUNCH
        (void)hipFuncSetAttribute((const void*)k_phase<0, 7>, hipFuncAttributeMaxDynamicSharedMemorySize, LDS_BYTES);
        (void)hipFuncSetAttribute((const void*)k_phase<1, 7>, hipFuncAttributeMaxDynamicSharedMemorySize, LDS_BYTES);
        (void)hipFuncSetAttribute((const void*)k_phase<2, 1>, hipFuncAttributeMaxDynamicSharedMemorySize, LDS_BYTES);
        (void)hipFuncSetAttribute((const void*)k_phase<2, 8>, hipFuncAttributeMaxDynamicSharedMemorySize, LDS_BYTES);
        (void)hipFuncSetAttribute((const void*)k_phase<2, 2>, hipFuncAttributeMaxDynamicSharedMemorySize, LDS_BYTES);
        (void)hipFuncSetAttribute((const void*)k_phase<2, 4>, hipFuncAttributeMaxDynamicSharedMemorySize, LDS_BYTES);
        (void)hipFuncSetAttribute((const void*)k_phase<3, 7>, hipFuncAttributeMaxDynamicSharedMemorySize, LDS_BYTES);
        (void)hipFuncSetAttribute((const void*)k_phase<4, 7>, hipFuncAttributeMaxDynamicSharedMemorySize, LDS_BYTES);
        (void)hipFuncSetAttribute((const void*)k_phase<5, 7>, hipFuncAttributeMaxDynamicSharedMemorySize, LDS_BYTES);
        (void)hipFuncSetAttribute((const void*)k_phase<6, 7>, hipFuncAttributeMaxDynamicSharedMemorySize, LDS_BYTES);
#else
        int per_cu = 0;
        (void)hipFuncSetAttribute((const void*)hybrid_fwd, hipFuncAttributeMaxDynamicSharedMemorySize, LDS_BYTES);
        (void)hipOccupancyMaxActiveBlocksPerMultiprocessor(&per_cu, (const void*)hybrid_fwd, 512, LDS_BYTES);
        if (per_cu < 1) fprintf(stderr, "kernel_launch: occupancy query says %d blocks per CU\n", per_cu);
#endif
        (void)hipGetLastError();
        grid = cus > 256 ? 256 : cus;
    }
    if (grid < 0) return;
    Args a{};
    a.x = (const float*)d_in[0]; a.p = (const float*)d_in[1]; a.pos = (const int*)d_in[2]; a.w_in = (const float*)d_in[3]; a.w_uq = (const float*)d_in[4]; a.w_ukv = (const float*)d_in[5];
    a.w_o = (const float*)d_in[6]; a.norm_g = (const float*)d_in[7]; a.q_norm_g = (const float*)d_in[8]; a.kv_norm_g = (const float*)d_in[9]; a.lam_q1 = (const float*)d_in[10]; a.lam_k1 = (const float*)d_in[11];
    a.lam_q2 = (const float*)d_in[12]; a.lam_k2 = (const float*)d_in[13]; a.subln_g = (const float*)d_in[14]; a.w_ple = (const float*)d_in[15]; a.w_pg = (const float*)d_in[16]; a.final_g = (const float*)d_in[17];
    a.out = (float*)d_out; a.ws = (unsigned char*)d_ws;
#ifdef MULTI_LAUNCH
    k_phase<0, 7><<<grid, 512, LDS_BYTES, stream>>>(a, 0);
    for (int L = 0; L < DEPTH; ++L) {
        k_phase<1, 7><<<grid, 512, LDS_BYTES, stream>>>(a, L); k_phase<2, 1><<<grid, 512, LDS_BYTES, stream>>>(a, L); k_phase<2, 8><<<grid, 512, LDS_BYTES, stream>>>(a, L); k_phase<2, 2><<<grid, 512, LDS_BYTES, stream>>>(a, L); k_phase<2, 4><<<grid, 512, LDS_BYTES, stream>>>(a, L); k_phase<3, 7><<<grid, 512, LDS_BYTES, stream>>>(a, L);
        k_phase<4, 7><<<grid, 512, LDS_BYTES, stream>>>(a, L); k_phase<5, 7><<<grid, 512, LDS_BYTES, stream>>>(a, L);
    }
    k_phase<6, 7><<<grid, 512, LDS_BYTES, stream>>>(a, 0);
#else
    void* args[] = {&a};
    hipError_t e = hipLaunchCooperativeKernel((const void*)hybrid_fwd, dim3(grid), dim3(512), args, LDS_BYTES, stream);
    if (e != hipSuccess) fprintf(stderr, "cooperative launch failed: %s (grid %d)\n", hipGetErrorString(e), grid);
#endif
}
```

```cpp
#include <hip/hip_runtime.h>
#include <hip/hip_cooperative_groups.h>
#include <cstdio>
#include <cstdint>
namespace cg = cooperative_groups;

constexpr int NBATCH = 4, SEQ = 4096, TOK = NBATCH * SEQ, DM = 2048, DEPTH = 4, PLE = 256;
constexpr int DIN = 7176, NIN = 7168;
constexpr int NUQ = 1152, NUQP = 1280, KUQ = 384;
constexpr int NUKV = 1536, KUKV = 256;
constexpr int NTAB = 56;
constexpr float EPS = 1e-6f, LOG2E = 1.4426950408889634f;
constexpr float SC_A = 0.07216878364870322f * LOG2E;
constexpr float SC_B = 0.08838834764831845f * LOG2E;
constexpr float SC_C = 0.125f * LOG2E;

constexpr size_t al256(size_t x) { return (x + 255) & ~(size_t)255; }
constexpr size_t WS_CTRL = 0;
constexpr int CW_BAR = 4096, CTRL_WORDS = 8192;
constexpr size_t WS_SSQH = 65536;
constexpr size_t WS_SSQQ = WS_SSQH + (size_t)TOK * 32 * 4;
constexpr size_t WS_SSQKV = WS_SSQQ + (size_t)TOK * 12 * 4;
constexpr size_t WS_ZERO_END = WS_SSQKV + (size_t)TOK * 8 * 4;
constexpr size_t WS_TAB = al256(WS_ZERO_END);
constexpr size_t WS_WIN = al256(WS_TAB + (size_t)TOK * NTAB * 8);
constexpr size_t WS_WUQ = al256(WS_WIN + (size_t)DEPTH * NIN * DM * 2);
constexpr size_t WS_WUKV = al256(WS_WUQ + (size_t)DEPTH * NUQP * KUQ * 2);
constexpr size_t WS_WO = al256(WS_WUKV + (size_t)DEPTH * NUKV * KUKV * 2);
constexpr size_t WS_WPG = al256(WS_WO + (size_t)DEPTH * DM * DM * 2);
constexpr size_t WS_WPLE = al256(WS_WPG + (size_t)DEPTH * DM * DM * 2);
constexpr size_t WS_PB = al256(WS_WPLE + (size_t)DEPTH * DM * PLE * 2);
constexpr size_t WS_HB = al256(WS_PB + (size_t)DEPTH * TOK * PLE * 2);
constexpr size_t WS_HB2 = al256(WS_HB + (size_t)TOK * DM * 2);
constexpr size_t WS_PLEO = al256(WS_HB2 + (size_t)TOK * DM * 2);
constexpr size_t WS_CQ = al256(WS_PLEO + (size_t)TOK * DM * 2);
constexpr size_t WS_CKV = al256(WS_CQ + (size_t)TOK * 384 * 2);
constexpr size_t WS_KROPE = al256(WS_CKV + (size_t)TOK * 256 * 2);
constexpr size_t WS_KIDX = al256(WS_KROPE + (size_t)TOK * 64 * 2);
constexpr size_t WS_GATE = al256(WS_KIDX + (size_t)TOK * 64 * 2);
constexpr size_t WS_QKB = al256(WS_GATE + (size_t)TOK * DM * 2);
constexpr size_t WS_VBC = al256(WS_QKB + (size_t)TOK * 1280 * 2);
constexpr size_t WS_QKC = al256(WS_VBC + (size_t)TOK * 1280 * 2);
constexpr size_t WS_QI = al256(WS_QKC + (size_t)TOK * 1280 * 2);
constexpr size_t WS_WIDX = al256(WS_QI + (size_t)TOK * 512 * 2);
constexpr size_t WS_QMLA = al256(WS_WIDX + (size_t)TOK * 8 * 4);
constexpr size_t WS_KMLA = al256(WS_QMLA + (size_t)TOK * 1152 * 2);
constexpr size_t WS_VMLA = al256(WS_KMLA + (size_t)TOK * 768 * 2);
constexpr size_t WS_MASK = al256(WS_VMLA + (size_t)TOK * 768 * 2);
constexpr size_t WS_W8T = al256(WS_MASK + (size_t)TOK * 64 * 8);
constexpr size_t WS_SCR = al256(WS_W8T + (size_t)DEPTH * 16 * DM * 2);
constexpr size_t SCR_PER_BLOCK = 512 * 1024;
constexpr size_t WS_END = WS_SCR;
static_assert(WS_END <= (size_t)940572672, "workspace map exceeds 4 x largest tensor");

constexpr int LDS_MAIN = 131072, LDS_BYTES = LDS_MAIN + 1024;
#define LAS __attribute__((address_space(3)))
#ifndef REP_A2
#define REP_A2 1
#endif
#ifndef REP_SEL
#define REP_SEL 1
#endif
#ifndef REP_A01
#define REP_A01 1
#endif
#ifndef REP_G1
#define REP_G1 1
#endif
#ifndef REP_P0
#define REP_P0 1
#endif
#ifndef REP_SYNC
#define REP_SYNC 1
#endif

constexpr int LDS_WTAB = LDS_MAIN + 64;
__device__ __forceinline__ int opaque_tid() {
    const unsigned hw = __builtin_amdgcn_s_getreg((5 << 11) | 4) & 63u;
    const int w = __builtin_amdgcn_readfirstlane(*(volatile LAS int*)(uintptr_t)(LDS_WTAB + hw * 4));
    unsigned z = 0u; asm volatile("" : "+v"(z));
    const int lane = (int)__builtin_amdgcn_mbcnt_hi(~0u, __builtin_amdgcn_mbcnt_lo(~0u, z));
    return (w << 6) | lane;
}

namespace pg8 {
#define PG8_LAS __attribute__((address_space(3)))
typedef unsigned short bf16_t;
typedef short bf16x8 __attribute__((ext_vector_type(8)));
typedef float f32x4 __attribute__((ext_vector_type(4)));
typedef unsigned u32x4 __attribute__((ext_vector_type(4)));
constexpr int BM = 256, BK = 64, HALF = 128, HTB = HALF * BK * 2  , STAGE_BYTES = 8 * HTB, NXCD = 8, WGM = 8;

__host__ __device__ __forceinline__ int lds_byte(int r, int c) { const int st = (r >> 4) * 2 + (c >> 5), rr = r & 15, cc = c & 31, ob = rr * 64 + cc * 2; return st * 1024 + (ob ^ (((ob >> 9) & 1) << 5)); }
__host__ __device__ __forceinline__ void stage_rc(int b, int& R, int& C) { const int st = b / 1024, sb = b % 1024, swz = sb ^ (((sb >> 9) & 1) << 5); R = (st >> 1) * 16 + swz / 64; C = (st & 1) * 32 + (swz % 64) / 2; }
__host__ __device__ __forceinline__ int perm32(int rho) { const int n = rho >> 4, i = rho & 15; return 8 * (i >> 2) + 4 * n + (i & 3); }

struct Unit { int pm, pn; };
struct Gemm { const bf16_t* A; const bf16_t* Bt; int M, N, K; };

struct StaticOrder {
    int nM, nN, nwg, G, c;
    __host__ __device__ void init(int M, int N, int G_, int c_) { nM = M / BM; nN = N / BM; nwg = nM * nN; G = G_; c = c_; }
    __host__ __device__ bool next(int i, Unit& u) const {
        const long L = (long)i * G + c; if (L >= nwg) return false;
        int wgid = (int)L; { const int q = nwg / NXCD, r = nwg % NXCD, xcd = wgid % NXCD, off = wgid / NXCD; wgid = (xcd < r ? xcd * (q + 1) : r * (q + 1) + (xcd - r) * q) + off; }
        const int nig = WGM * nN, gid = wgid / nig, fm = gid * WGM, gsz = (nM - fm) < WGM ? (nM - fm) : WGM;
        u.pm = fm + ((wgid % nig) % gsz); u.pn = (wgid % nig) / gsz; return true;
    }
    __device__ __forceinline__ void a_ready(const Unit&) const {}
    __device__ __forceinline__ void done(const Unit&) const {}
};

__device__ __forceinline__ unsigned cvt_pk_bf16(float lo, float hi) { unsigned r; asm volatile("v_cvt_pk_bf16_f32 %0, %1, %2" : "=v"(r) : "v"(lo), "v"(hi)); return r; }
typedef float f32x2 __attribute__((ext_vector_type(2)));
typedef float2 tab_t;
__device__ __forceinline__ void rope8(float (&v)[8], const tab_t* tp) {
    const f32x4 t0 = *(const f32x4*)tp, t1 = *(const f32x4*)(tp + 2);
    const float c[4] = {t0[0], t0[2], t1[0], t1[2]}, s[4] = {t0[1], t0[3], t1[1], t1[3]};
#pragma unroll
    for (int j = 0; j < 4; ++j) { const float a = v[2 * j], b = v[2 * j + 1]; v[2 * j] = a * c[j] - b * s[j]; v[2 * j + 1] = b * c[j] + a * s[j]; }
}
__device__ __forceinline__ void store8(bf16_t* p, const float (&v)[8]) {
    u32x4 w; w.x = cvt_pk_bf16(v[0], v[1]); w.y = cvt_pk_bf16(v[2], v[3]); w.z = cvt_pk_bf16(v[4], v[5]); w.w = cvt_pk_bf16(v[6], v[7]);
    *(u32x4*)p = w;
}
template <int N4> __device__ __forceinline__ float sum_parts(const float* p) {
    f32x4 a = *(const f32x4*)p;
#pragma unroll
    for (int i = 1; i < N4; ++i) a += *(const f32x4*)(p + 4 * i);
    return (a[0] + a[1]) + (a[2] + a[3]);
}
__device__ __forceinline__ float silu_f(float x) { return x * __builtin_amdgcn_rcpf(1.0f + __builtin_amdgcn_exp2f(-x * 1.4426950408889634f)); }
__device__ __forceinline__ float sigmoid_f(float x) { return __builtin_amdgcn_rcpf(1.0f + __builtin_amdgcn_exp2f(-x * 1.4426950408889634f)); }

struct EpiIn {
    static constexpr bool PERM = true, AFTER_DRAIN = false;
    const float* ssq_h; float* ssq_q; float* ssq_kv;
    bf16_t *CQ, *CKV, *KROPE, *KIDX, *GATE, *QKB, *VBC, *QKC, *QI; const tab_t* TAB;
    __device__ __forceinline__ void operator()(const f32x4 (&acc)[2][2][4][2], const Unit& u, int wr, int wc, int fr, int fq) const {
        { const int t_ = opaque_tid(), w_ = __builtin_amdgcn_readfirstlane(t_ >> 6), l_ = t_ & 63; wr = w_ >> 2; wc = w_ & 3; fr = l_ & 15; fq = l_ >> 4; }
        const int pn = u.pn, row0 = u.pm * BM + wr * 64 + fr;
        bf16_t* dst[2]; int ld[2], tab[2], act[2], sld[2]; float sc[2]; float* ssq[2];
#pragma unroll
        for (int bj = 0; bj < 2; ++bj) {
            const int cc = bj * HALF + wc * 32 + fq * 8, n = pn * BM + cc;
            bf16_t* d = nullptr; int l = 0, col = 0, tb = -1, ac = 0, sl = 0; float s = 1.f; float* sq = nullptr;
            if (pn == 0) { d = CQ; l = 384; col = n; sq = ssq_q + bj * 4 + wc; sl = 12; }
            else if (pn == 1) {
                if (cc < 128) { d = CQ; l = 384; col = 256 + cc; sq = ssq_q + 8 + wc; sl = 12; }
                else if (cc < 192) { d = KROPE; l = 64; col = cc - 128; tb = (cc - 128) >> 1; }
                else { d = KIDX; l = 64; col = cc - 192; if (col < 16) tb = 48 + (col >> 1); }
            }
            else if (pn == 2) { d = CKV; l = 256; col = cc; sq = ssq_kv + bj * 4 + wc; sl = 8; }
            else if (pn < 11) { d = GATE; l = 2048; col = n - 768; ac = 1; }
            else if (pn < 16) { const int j = n - 2816; d = QKB; l = 1280; col = j; const int dd = j & 127; if (dd < 32) tb = 32 + (dd >> 1); if (j < 640) s = SC_B; }
            else if (pn < 21) { d = VBC; l = 1280; col = n - 4096; }
            else if (pn < 26) { const int j = n - 5376; d = QKC; l = 1280; col = j; const int dd = j & 63; if (dd < 16) tb = 48 + (dd >> 1); if (j < 640) s = SC_C; }
            else { const int j = n - 6656; d = QI; l = 512; col = j; const int dd = j & 63; if (dd < 16) tb = 48 + (dd >> 1); }
            dst[bj] = d + col; ld[bj] = l; tab[bj] = tb; act[bj] = ac; sld[bj] = sl; sc[bj] = s; ssq[bj] = sq;
        }
#pragma unroll
        for (int ai = 0; ai < 2; ++ai)
#pragma unroll
            for (int m = 0; m < 4; ++m) {
                const int row = row0 + ai * HALF + m * 16;
                const float r = __builtin_amdgcn_rsqf(sum_parts<8>(ssq_h + (size_t)row * 32) * (1.0f / 2048.0f) + 1e-6f);
#pragma unroll
                for (int bj = 0; bj < 2; ++bj) {
                    float v[8];
#pragma unroll
                    for (int e = 0; e < 4; ++e) { v[e] = acc[ai][bj][m][0][e] * r; v[4 + e] = acc[ai][bj][m][1][e] * r; }
                    if (tab[bj] >= 0) rope8(v, TAB + (size_t)row * NTAB + tab[bj]);
                    if (act[bj]) {
#pragma unroll
                        for (int e = 0; e < 8; ++e) v[e] = silu_f(v[e]);
                    }
#pragma unroll
                    for (int e = 0; e < 8; ++e) v[e] *= sc[bj];
                    if (ssq[bj]) { float s = 0.f;
#pragma unroll
                        for (int e = 0; e < 8; ++e) s += v[e] * v[e];
                        s += __shfl_xor(s, 16); s += __shfl_xor(s, 32);
                        if (fq == 0) ssq[bj][(size_t)row * sld[bj]] = s; }
                    store8(dst[bj] + (size_t)row * ld[bj], v);
                    asm volatile("" ::: "memory");
                }
            }
    }
};
struct EpiPlain {
    static constexpr bool PERM = true, AFTER_DRAIN = false;
    bf16_t* O; int ldc;
    __device__ __forceinline__ void operator()(const f32x4 (&acc)[2][2][4][2], const Unit& u, int wr, int wc, int fr, int fq) const {
        { const int t_ = opaque_tid(), w_ = __builtin_amdgcn_readfirstlane(t_ >> 6), l_ = t_ & 63; wr = w_ >> 2; wc = w_ & 3; fr = l_ & 15; fq = l_ >> 4; }
        const int row0 = u.pm * BM + wr * 64 + fr;
#pragma unroll
        for (int bj = 0; bj < 2; ++bj) { const int col = u.pn * BM + bj * HALF + wc * 32 + fq * 8;
#pragma unroll
            for (int ai = 0; ai < 2; ++ai)
#pragma unroll
                for (int m = 0; m < 4; ++m) { const int row = row0 + ai * HALF + m * 16; float v[8];
#pragma unroll
                    for (int e = 0; e < 4; ++e) { v[e] = acc[ai][bj][m][0][e]; v[4 + e] = acc[ai][bj][m][1][e]; }
                    store8(O + (size_t)row * ldc + col, v); } }
    }
};
struct EpiUq {
    static constexpr bool PERM = true, AFTER_DRAIN = false;
    const float* ssq; bf16_t* Q;
    __device__ __forceinline__ void operator()(const f32x4 (&acc)[2][2][4][2], const Unit& u, int wr, int wc, int fr, int fq) const {
        { const int t_ = opaque_tid(), w_ = __builtin_amdgcn_readfirstlane(t_ >> 6), l_ = t_ & 63; wr = w_ >> 2; wc = w_ & 3; fr = l_ & 15; fq = l_ >> 4; }
        const int row0 = u.pm * BM + wr * 64 + fr;
#pragma unroll
        for (int bj = 0; bj < 2; ++bj) { const int n = u.pn * BM + bj * HALF + wc * 32 + fq * 8;
            if (n < NUQ) {
#pragma unroll
            for (int ai = 0; ai < 2; ++ai)
#pragma unroll
                for (int m = 0; m < 4; ++m) { const int row = row0 + ai * HALF + m * 16;
                    const float r = __builtin_amdgcn_rsqf(sum_parts<3>(ssq + (size_t)row * 12) * (1.0f / 384.0f) + 1e-6f) * SC_A; float v[8];
#pragma unroll
                    for (int e = 0; e < 4; ++e) { v[e] = acc[ai][bj][m][0][e] * r; v[4 + e] = acc[ai][bj][m][1][e] * r; }
                    store8(Q + (size_t)row * NUQ + n, v); asm volatile("" ::: "memory"); } } }
    }
};
struct EpiUkv {
    static constexpr bool PERM = true, AFTER_DRAIN = false;
    const float* ssq; bf16_t* Kd; bf16_t* Vd;
    __device__ __forceinline__ void operator()(const f32x4 (&acc)[2][2][4][2], const Unit& u, int wr, int wc, int fr, int fq) const {
        { const int t_ = opaque_tid(), w_ = __builtin_amdgcn_readfirstlane(t_ >> 6), l_ = t_ & 63; wr = w_ >> 2; wc = w_ & 3; fr = l_ & 15; fq = l_ >> 4; }
        const int row0 = u.pm * BM + wr * 64 + fr;
        bf16_t* dst[2];
#pragma unroll
        for (int bj = 0; bj < 2; ++bj) { const int n = u.pn * BM + bj * HALF + wc * 32 + fq * 8; const int hd = n >> 8, d = n & 255; dst[bj] = (d < 128) ? (Kd + hd * 128 + d) : (Vd + hd * 128 + d - 128); }
#pragma unroll
        for (int ai = 0; ai < 2; ++ai)
#pragma unroll
            for (int m = 0; m < 4; ++m) { const int row = row0 + ai * HALF + m * 16;
                const float r = __builtin_amdgcn_rsqf(sum_parts<2>(ssq + (size_t)row * 8) * (1.0f / 256.0f) + 1e-6f);
#pragma unroll
                for (int bj = 0; bj < 2; ++bj) { float v[8];
#pragma unroll
                    for (int e = 0; e < 4; ++e) { v[e] = acc[ai][bj][m][0][e] * r; v[4 + e] = acc[ai][bj][m][1][e] * r; }
                    store8(dst[bj] + (size_t)row * 768, v); }
                asm volatile("" ::: "memory"); }
    }
};
struct EpiWo {
    static constexpr bool PERM = true, AFTER_DRAIN = false;
    const bf16_t* HBi; bf16_t* HBo;
    __device__ __forceinline__ void operator()(const f32x4 (&acc)[2][2][4][2], const Unit& u, int wr, int wc, int fr, int fq) const {
        { const int t_ = opaque_tid(), w_ = __builtin_amdgcn_readfirstlane(t_ >> 6), l_ = t_ & 63; wr = w_ >> 2; wc = w_ & 3; fr = l_ & 15; fq = l_ >> 4; }
        const int row0 = u.pm * BM + wr * 64 + fr;
#pragma unroll
        for (int bj = 0; bj < 2; ++bj) { const int col = u.pn * BM + bj * HALF + wc * 32 + fq * 8;
            u32x4 hw[2][4];
#pragma unroll
            for (int ai = 0; ai < 2; ++ai)
#pragma unroll
                for (int m = 0; m < 4; ++m) hw[ai][m] = *(const u32x4*)(HBi + (size_t)(row0 + ai * HALF + m * 16) * DM + col);
            asm volatile("" ::: "memory");
#pragma unroll
            for (int ai = 0; ai < 2; ++ai)
#pragma unroll
                for (int m = 0; m < 4; ++m) { const size_t off = (size_t)(row0 + ai * HALF + m * 16) * DM + col; float v[8];
#pragma unroll
                    for (int e2 = 0; e2 < 4; ++e2) { const unsigned g = hw[ai][m][e2];
                        const float a0 = (e2 < 2) ? acc[ai][bj][m][0][2 * e2] : acc[ai][bj][m][1][2 * e2 - 4], a1 = (e2 < 2) ? acc[ai][bj][m][0][2 * e2 + 1] : acc[ai][bj][m][1][2 * e2 - 3];
                        v[2 * e2] = __uint_as_float(g << 16) + a0; v[2 * e2 + 1] = __uint_as_float(g & 0xffff0000u) + a1; }
                    store8(HBo + off, v); }
            asm volatile("" ::: "memory"); }
    }
};
struct EpiPg {
    static constexpr bool PERM = true, AFTER_DRAIN = false;
    bf16_t* HBo; const bf16_t* P; float* ssq; const bf16_t* HBi;
    __device__ __forceinline__ void operator()(const f32x4 (&acc)[2][2][4][2], const Unit& u, int wr, int wc, int fr, int fq) const {
        { const int t_ = opaque_tid(), w_ = __builtin_amdgcn_readfirstlane(t_ >> 6), l_ = t_ & 63; wr = w_ >> 2; wc = w_ & 3; fr = l_ & 15; fq = l_ >> 4; }
        const int row0 = u.pm * BM + wr * 64 + fr;
#pragma unroll
        for (int ai = 0; ai < 2; ++ai) {
            float s[4] = {0.f, 0.f, 0.f, 0.f};
#pragma unroll
            for (int bj = 0; bj < 2; ++bj) { const int col = u.pn * BM + bj * HALF + wc * 32 + fq * 8;
                u32x4 hw[4], pw[4];
#pragma unroll
                for (int m = 0; m < 4; ++m) { const size_t off = (size_t)(row0 + ai * HALF + m * 16) * DM + col; hw[m] = *(const u32x4*)(HBi + off); pw[m] = *(const u32x4*)(P + off); }
                asm volatile("" ::: "memory");
#pragma unroll
                for (int m = 0; m < 4; ++m) { const size_t off = (size_t)(row0 + ai * HALF + m * 16) * DM + col; float v[8];
#pragma unroll
                    for (int e = 0; e < 4; ++e) {
                        const unsigned w = pw[m][e]; const float p0 = __uint_as_float(w << 16), p1 = __uint_as_float(w & 0xffff0000u);
                        const unsigned g = hw[m][e]; const float b0 = __uint_as_float(g << 16), b1 = __uint_as_float(g & 0xffff0000u);
                        const float a0 = (e < 2) ? acc[ai][bj][m][0][2 * e] : acc[ai][bj][m][1][2 * e - 4], a1 = (e < 2) ? acc[ai][bj][m][0][2 * e + 1] : acc[ai][bj][m][1][2 * e - 3];
                        v[2 * e] = b0 + p0 * sigmoid_f(a0); v[2 * e + 1] = b1 + p1 * sigmoid_f(a1); }
#pragma unroll
                    for (int e = 0; e < 8; ++e) s[m] += v[e] * v[e];
                    store8(HBo + off, v); }
                asm volatile("" ::: "memory"); }
#pragma unroll
            for (int m = 0; m < 4; ++m) { float t = s[m]; t += __shfl_xor(t, 16); t += __shfl_xor(t, 32);
                if (fq == 0) ssq[(size_t)(row0 + ai * HALF + m * 16) * 32 + u.pn * 4 + wc] = t; }
        }
    }
};
template <class Epi, class Sched, bool ALIGN_EPI = false, bool SP2 = false>
__device__ __forceinline__ void gemm_phase(PG8_LAS unsigned char* lds, const Gemm g, const Sched& S, const Epi& E) {
    const int tid = opaque_tid(), wid = __builtin_amdgcn_readfirstlane(tid >> 6), lane = tid & 63, wr = wid >> 2, wc = wid & 3, fr = lane & 15, fq = lane >> 4;
    const int K = g.K, nt = K / BK;
    unsigned voffA[2], voffB[2];
#pragma unroll
    for (int i = 0; i < 2; ++i) { int R, C; stage_rc(tid * 16 + i * 8192, R, C); const int Rb = Epi::PERM ? ((R & ~31) + perm32(R & 31)) : R;
        voffA[i] = (unsigned)(R * K + C) * 2u; voffB[i] = (unsigned)(Rb * K + C) * 2u; }
    const size_t kstep = (size_t)(BK * 2);
    const size_t hstep = (size_t)HALF * K * 2;
    const size_t tstep = 2 * hstep;
    const unsigned ldsw = (unsigned)wid * 1024u;
    const int aoff = lds_byte(wr * 64 + fr, fq * 8), boff = lds_byte(wc * 32 + fr, fq * 8);
#define PG8_SA(b, h) (((b) * 2 + (h)) * HTB)
#define PG8_SB(b, h) ((4 + (b) * 2 + (h)) * HTB)
#define PG8_STAGE(bufoff, gbase, voff) do { _Pragma("unroll") for (int _i = 0; _i < 2; ++_i) \
        __builtin_amdgcn_global_load_lds((const unsigned*)((const char*)(gbase) + (voff)[_i]), (PG8_LAS unsigned*)(lds + (bufoff) + ldsw + _i * 8192), 16, 0, 0); } while (0)
#define PG8_LDA(dst, b, h) do { _Pragma("unroll") for (int m = 0; m < 4; ++m) _Pragma("unroll") for (int k = 0; k < 2; ++k) dst[m][k] = *(const PG8_LAS bf16x8*)(lds + PG8_SA(b, h) + aoff + m * 2048 + k * 1024); } while (0)
#define PG8_LDB(dst, b, h) do { _Pragma("unroll") for (int n = 0; n < 2; ++n) _Pragma("unroll") for (int k = 0; k < 2; ++k) dst[n][k] = *(const PG8_LAS bf16x8*)(lds + PG8_SB(b, h) + boff + n * 2048 + k * 1024); } while (0)
#define PG8_MMA(ai, bj, At, Bt) do { __builtin_amdgcn_s_setprio(1); _Pragma("unroll") for (int m = 0; m < 4; ++m) _Pragma("unroll") for (int n = 0; n < 2; ++n) _Pragma("unroll") for (int k = 0; k < 2; ++k) \
        acc[ai][bj][m][n] = __builtin_amdgcn_mfma_f32_16x16x32_bf16(Bt[n][k], At[m][k], acc[ai][bj][m][n], 0, 0, 0); __builtin_amdgcn_s_setprio(0); } while (0)
#define PG8_WAIT_V(n) asm volatile("s_waitcnt vmcnt(" #n ")" ::: "memory")
#define PG8_WAIT_L(n) asm volatile("s_waitcnt lgkmcnt(" #n ")" ::: "memory")
#define PG8_BAR __builtin_amdgcn_s_barrier()
#define PG8_SCHED __builtin_amdgcn_sched_barrier(0)
    Unit cur, nxt; int ui = 0;
    if (!S.next(0, cur)) return;
    f32x4 acc[2][2][4][2];
#pragma unroll
    for (int a = 0; a < 2; ++a)
#pragma unroll
        for (int b = 0; b < 2; ++b)
#pragma unroll
            for (int m = 0; m < 4; ++m)
#pragma unroll
                for (int n = 0; n < 2; ++n) acc[a][b][m][n] = (f32x4){0.f, 0.f, 0.f, 0.f};
    bf16x8 At[4][2], B0[2][2], B1[2][2];
    const char* cA = (const char*)g.A + (size_t)cur.pm * tstep; const char* cB = (const char*)g.Bt + (size_t)cur.pn * tstep;
    S.a_ready(cur);
    if constexpr (SP2) {
        PG8_STAGE(PG8_SB(0, 0), cB, voffB); PG8_STAGE(PG8_SB(0, 1), cB + hstep, voffB); PG8_STAGE(PG8_SA(0, 0), cA, voffA); PG8_STAGE(PG8_SA(0, 1), cA + hstep, voffA);
        if (wr == 1) PG8_BAR;
        PG8_WAIT_V(2); PG8_BAR;
        PG8_STAGE(PG8_SB(1, 0), cB + kstep, voffB); PG8_STAGE(PG8_SA(1, 0), cA + kstep, voffA); PG8_STAGE(PG8_SB(1, 1), cB + hstep + kstep, voffB);
        PG8_WAIT_V(6); PG8_BAR;
    } else {
        PG8_STAGE(PG8_SB(0, 0), cB, voffB); PG8_STAGE(PG8_SA(0, 0), cA, voffA); PG8_STAGE(PG8_SB(0, 1), cB + hstep, voffB); PG8_STAGE(PG8_SA(0, 1), cA + hstep, voffA);
        if (wr == 1) PG8_BAR;
        PG8_WAIT_V(4); PG8_BAR;
        PG8_STAGE(PG8_SB(1, 0), cB + kstep, voffB); PG8_STAGE(PG8_SA(1, 0), cA + kstep, voffA); PG8_STAGE(PG8_SB(1, 1), cB + hstep + kstep, voffB);
        PG8_WAIT_V(6); PG8_BAR;
    }
    for (;;) {
        const bool has_next = S.next(ui + 1, nxt);
        const char* nA = has_next ? (const char*)g.A + (size_t)nxt.pm * tstep : cA; const char* nB = has_next ? (const char*)g.Bt + (size_t)nxt.pn * tstep : cB;
        for (int t = 0; t < nt; t += 2) {
            const bool last = (t == nt - 2);
            const char* a1 = cA + (size_t)(t + 1) * kstep;
            const char* a2 = last ? nA : cA + (size_t)(t + 2) * kstep; const char* b2 = last ? nB : cB + (size_t)(t + 2) * kstep;
            const char* a3 = a2 + kstep; const char* b3 = b2 + kstep;
            if (last && has_next) S.a_ready(nxt);
            if constexpr (SP2) {
            PG8_LDB(B0, 0, 0); PG8_LDB(B1, 0, 1); PG8_SCHED; PG8_LDA(At, 0, 0); PG8_STAGE(PG8_SA(1, 1), a1 + hstep, voffA);
            PG8_WAIT_V(8); PG8_WAIT_L(0); PG8_BAR; PG8_MMA(0, 0, At, B0); PG8_MMA(0, 1, At, B1); PG8_BAR; PG8_SCHED;
            PG8_LDA(At, 0, 1); PG8_STAGE(PG8_SB(0, 0), b2, voffB); PG8_STAGE(PG8_SB(0, 1), b2 + hstep, voffB); PG8_STAGE(PG8_SA(0, 0), a2, voffA);
            PG8_WAIT_V(8); PG8_WAIT_L(0); PG8_BAR; PG8_MMA(1, 0, At, B0); PG8_MMA(1, 1, At, B1); PG8_BAR; PG8_SCHED;
            PG8_LDB(B0, 1, 0); PG8_LDB(B1, 1, 1); PG8_SCHED; PG8_LDA(At, 1, 0); PG8_STAGE(PG8_SA(0, 1), a2 + hstep, voffA);
            PG8_WAIT_V(8); PG8_WAIT_L(0); PG8_BAR; PG8_MMA(0, 0, At, B0); PG8_MMA(0, 1, At, B1); PG8_BAR; PG8_SCHED;
            PG8_LDA(At, 1, 1); PG8_STAGE(PG8_SB(1, 0), b3, voffB); PG8_STAGE(PG8_SB(1, 1), b3 + hstep, voffB); PG8_STAGE(PG8_SA(1, 0), a3, voffA);
            PG8_WAIT_V(8); PG8_WAIT_L(0); PG8_BAR; PG8_MMA(1, 0, At, B0); PG8_MMA(1, 1, At, B1); PG8_BAR; PG8_SCHED;
            } else {
            PG8_LDB(B0, 0, 0); PG8_SCHED; PG8_LDA(At, 0, 0); PG8_STAGE(PG8_SA(1, 1), a1 + hstep, voffA);
            PG8_WAIT_L(8); PG8_BAR; PG8_WAIT_L(0); PG8_MMA(0, 0, At, B0); PG8_BAR; PG8_SCHED;
            PG8_LDB(B1, 0, 1); PG8_STAGE(PG8_SB(0, 0), b2, voffB);
            PG8_BAR; PG8_WAIT_L(0); PG8_MMA(0, 1, At, B1); PG8_BAR;
            PG8_LDA(At, 0, 1); PG8_STAGE(PG8_SA(0, 0), a2, voffA);
            PG8_BAR; PG8_WAIT_L(0); PG8_MMA(1, 0, At, B0); PG8_BAR; PG8_SCHED;
            PG8_STAGE(PG8_SB(0, 1), b2 + hstep, voffB);
            PG8_WAIT_V(6); PG8_BAR; PG8_MMA(1, 1, At, B1); PG8_BAR;
            PG8_LDB(B0, 1, 0); PG8_SCHED; PG8_LDA(At, 1, 0); PG8_STAGE(PG8_SA(0, 1), a2 + hstep, voffA);
            PG8_WAIT_L(8); PG8_BAR; PG8_WAIT_L(0); PG8_MMA(0, 0, At, B0); PG8_BAR; PG8_SCHED;
            PG8_LDB(B1, 1, 1); PG8_STAGE(PG8_SB(1, 0), b3, voffB);
            PG8_BAR; PG8_WAIT_L(0); PG8_MMA(0, 1, At, B1); PG8_BAR;
            PG8_LDA(At, 1, 1); PG8_STAGE(PG8_SA(1, 0), a3, voffA);
            PG8_BAR; PG8_WAIT_L(0); PG8_MMA(1, 0, At, B0); PG8_BAR; PG8_SCHED;
            PG8_STAGE(PG8_SB(1, 1), b3 + hstep, voffB);
            PG8_WAIT_V(6); PG8_BAR; PG8_MMA(1, 1, At, B1); PG8_BAR;
            }
        }
        if constexpr (ALIGN_EPI) { if (wr == 0) PG8_BAR; }
        if constexpr (!Epi::AFTER_DRAIN) { E(acc, cur, wr, wc, fr, fq); S.done(cur); }
        if (!has_next) break;
#pragma unroll
        for (int a = 0; a < 2; ++a)
#pragma unroll
            for (int b = 0; b < 2; ++b)
#pragma unroll
                for (int m = 0; m < 4; ++m)
#pragma unroll
                    for (int n = 0; n < 2; ++n) acc[a][b][m][n] = (f32x4){0.f, 0.f, 0.f, 0.f};
        cur = nxt; cA = nA; cB = nB; ++ui;
        if constexpr (ALIGN_EPI) { if (wr == 1) PG8_BAR; }
    }
    PG8_WAIT_V(0);
    if constexpr (!ALIGN_EPI) { if (wr == 0) PG8_BAR; }
    PG8_BAR;
    if constexpr (Epi::AFTER_DRAIN) { E.fused(acc, cur, wr, wc, fr, fq, lds, wid, lane); S.done(cur); }
#undef PG8_SA
#undef PG8_SB
#undef PG8_STAGE
#undef PG8_LDA
#undef PG8_LDB
#undef PG8_MMA
#undef PG8_WAIT_V
#undef PG8_WAIT_L
#undef PG8_BAR
#undef PG8_SCHED
}
}
namespace att {
typedef short bf16x8 __attribute__((ext_vector_type(8)));
typedef short s16x4 __attribute__((ext_vector_type(4)));
typedef float f32x16 __attribute__((ext_vector_type(16)));
typedef float f32x4 __attribute__((ext_vector_type(4)));
typedef unsigned u32x4 __attribute__((ext_vector_type(4)));
typedef unsigned u32x2 __attribute__((ext_vector_type(2)));
typedef unsigned short bf16_t;
typedef LAS const char* lptr;
constexpr int ST_K = 0, ST_V = 16384, ST_K64 = 32768, ST_BYTES = 40960;

__device__ __forceinline__ unsigned offb(unsigned row, unsigned ch) { return 256u * row + 16u * (ch ^ (((row & 3) << 2) | ((row >> 2) & 3))); }
__device__ __forceinline__ unsigned off64(unsigned row, unsigned ch) { return 128u * row + 16u * (ch ^ ((row >> 1) & 7)); }
__device__ __forceinline__ unsigned cvtpk(float lo, float hi) { unsigned r; asm("v_cvt_pk_bf16_f32 %0, %1, %2" : "=v"(r) : "v"(lo), "v"(hi)); return r; }
__device__ __forceinline__ s16x4 vtr(lptr p) { typedef short v4i16_t __attribute__((ext_vector_type(4))); return __builtin_bit_cast(s16x4, __builtin_amdgcn_ds_read_tr16_b64_v4i16((LAS v4i16_t*)p)); }
__device__ __forceinline__ float max_x32(float v) { const unsigned u = __float_as_uint(v); auto r = __builtin_amdgcn_permlane32_swap(u, u, false, false); return fmaxf(__uint_as_float(r[0]), __uint_as_float(r[1])); }
__device__ __forceinline__ float sum_x32(float v) { const unsigned u = __float_as_uint(v); auto r = __builtin_amdgcn_permlane32_swap(u, u, false, false); return __uint_as_float(r[0]) + __uint_as_float(r[1]); }
__device__ __forceinline__ float bf_lo(unsigned w) { return __uint_as_float(w << 16); }
__device__ __forceinline__ float bf_hi(unsigned w) { return __uint_as_float(w & 0xffff0000u); }

template <bool MASKED>
__device__ __forceinline__ void softmax_tile(f32x16& s0, f32x16& s1, float& m, float& l, float& alpha, unsigned mlo, unsigned mhi, bf16x8 (&pk)[4]) {
    const float NEG = -1e30f;
    if (MASKED) {
#pragma unroll
        for (int r = 0; r < 16; ++r) { const int bit = (r & 3) + 8 * (r >> 2); if (!((mlo >> bit) & 1u)) s0[r] = NEG; if (!((mhi >> bit) & 1u)) s1[r] = NEG; }
    }
    float mx = fmaxf(s0[0], s1[0]);
#pragma unroll
    for (int r = 1; r < 16; ++r) mx = fmaxf(mx, fmaxf(s0[r], s1[r]));
    mx = max_x32(mx);
    const float mn = fmaxf(m, mx);
    alpha = __builtin_amdgcn_exp2f(m - mn); m = mn;
    float sum = 0.f;
#pragma unroll
    for (int r = 0; r < 16; ++r) {
        float p0 = __builtin_amdgcn_exp2f(s0[r] - mn), p1 = __builtin_amdgcn_exp2f(s1[r] - mn);
        if (MASKED) { if (s0[r] <= -1e29f) p0 = 0.f; if (s1[r] <= -1e29f) p1 = 0.f; }
        s0[r] = p0; s1[r] = p1; sum += p0 + p1;
    }
    l = l * alpha + sum;
#pragma unroll
    for (int k2 = 0; k2 < 2; ++k2) {
        u32x4 a, b;
        a.x = cvtpk(s0[8 * k2 + 0], s0[8 * k2 + 1]); a.y = cvtpk(s0[8 * k2 + 2], s0[8 * k2 + 3]); a.z = cvtpk(s0[8 * k2 + 4], s0[8 * k2 + 5]); a.w = cvtpk(s0[8 * k2 + 6], s0[8 * k2 + 7]);
        b.x = cvtpk(s1[8 * k2 + 0], s1[8 * k2 + 1]); b.y = cvtpk(s1[8 * k2 + 2], s1[8 * k2 + 3]); b.z = cvtpk(s1[8 * k2 + 4], s1[8 * k2 + 5]); b.w = cvtpk(s1[8 * k2 + 6], s1[8 * k2 + 7]);
        pk[k2] = __builtin_bit_cast(bf16x8, a); pk[2 + k2] = __builtin_bit_cast(bf16x8, b);
    }
}

struct AttnPtrs {
    const bf16_t* Q; int ldq;
    const bf16_t* K; int ldk;
    const bf16_t* K64;
    const bf16_t* V; int ldv;
    const bf16_t* G; bf16_t* Go;
    const unsigned long long* MASK;
    float lam, c_out; const float* subg;
};

template <int MODE>
__device__ __forceinline__ void attn_unit(LAS char* lds, const AttnPtrs& A, int b, int qb) {
    constexpr int NQ = (MODE == 0) ? 12 : (MODE == 1 ? 8 : 4);
    const int tid = opaque_tid(), lane = tid & 63, r32 = lane & 31, hi = lane >> 5, wid = __builtin_amdgcn_readfirstlane(tid >> 6);
    const int strm = (MODE == 2) ? (wid & 1) : 0;
    const size_t rowbase = (size_t)b * SEQ; const int q0 = (MODE == 2) ? qb * 128 + (wid >> 1) * 32 : qb * 256 + wid * 32; const int cw = q0 >> 6, NT = (MODE == 2) ? 2 * qb + 2 : 4 * qb + 4;
    const size_t qrow = rowbase + q0 + r32;
    const bf16_t* ksrc[2]; const bf16_t* vsrc[2];
#pragma unroll
    for (int i = 0; i < 2; ++i) { const unsigned row = 4u * (2 * wid + i) + (lane >> 4), ch = (lane & 15) ^ (((row & 3) << 2) | ((row >> 2) & 3));
        ksrc[i] = A.K + (rowbase + row) * A.ldk + ch * 8; vsrc[i] = A.V + (rowbase + row) * A.ldv + ch * 8; }
    const bf16_t* k64src = nullptr;
    if constexpr (MODE == 0) { const unsigned row = 8u * wid + (lane >> 3), ch = (lane & 7) ^ ((row >> 1) & 7); k64src = A.K64 + (rowbase + row) * 64 + ch * 8; }
    const unsigned fK = ((r32 & 3) << 2) | ((r32 >> 2) & 3);
    const unsigned g64 = (r32 >> 1) & 7;
    const int q4 = (lane & 15) >> 2, p4 = lane & 3, blk = (lane >> 4) & 1;
    unsigned vrow[2], vlow[2];
#pragma unroll
    for (int t = 0; t < 2; ++t) { vrow[t] = 4 * hi + 8 * t + q4; vlow[t] = (unsigned)((2 * blk + (p4 >> 1)) ^ ((hi + 2 * t) & 3)); }
#define DMA16(src_, ldsoff_) __builtin_amdgcn_global_load_lds((const unsigned*)(src_), (LAS unsigned*)(lds + (ldsoff_)), 16, 0, 0)
#define STAGE(t_, st_) do { const size_t o_ = (size_t)(t_) * 64; const int sb_ = (st_) * ST_BYTES + wid * 2048; \
        DMA16(ksrc[0] + o_ * A.ldk, sb_ + ST_K); DMA16(ksrc[1] + o_ * A.ldk, sb_ + ST_K + 1024); \
        DMA16(vsrc[0] + o_ * A.ldv, sb_ + ST_V); DMA16(vsrc[1] + o_ * A.ldv, sb_ + ST_V + 1024); \
        if constexpr (MODE == 0) DMA16(k64src + o_ * 64, (st_) * ST_BYTES + ST_K64 + wid * 1024); } while (0)
    STAGE(0, 0); STAGE(1, 1);
    bf16x8 qf[NQ];
#pragma unroll
    for (int s = 0; s < NQ; ++s) qf[s] = *(const bf16x8*)(A.Q + qrow * A.ldq + 64 * strm + 16 * s + 8 * hi);
    if constexpr (MODE == 0) {
#pragma unroll
        for (int s = 0; s < 4; ++s) {
            const u32x4 w = __builtin_bit_cast(u32x4, qf[8 + s]);
            const f32x4 t0 = *(const f32x4*)(A.subg + (qrow * 56 + 8 * s + 4 * hi) * 2), t1 = *(const f32x4*)(A.subg + (qrow * 56 + 8 * s + 4 * hi) * 2 + 4);
            u32x4 o;
            { const float a = bf_lo(w.x), b = bf_hi(w.x); o.x = cvtpk(a * t0[0] - b * t0[1], b * t0[0] + a * t0[1]); }
            { const float a = bf_lo(w.y), b = bf_hi(w.y); o.y = cvtpk(a * t0[2] - b * t0[3], b * t0[2] + a * t0[3]); }
            { const float a = bf_lo(w.z), b = bf_hi(w.z); o.z = cvtpk(a * t1[0] - b * t1[1], b * t1[0] + a * t1[1]); }
            { const float a = bf_lo(w.w), b = bf_hi(w.w); o.w = cvtpk(a * t1[2] - b * t1[3], b * t1[2] + a * t1[3]); }
            qf[8 + s] = __builtin_bit_cast(bf16x8, o);
        }
    }
#pragma unroll
    for (int s = 0; s < NQ; ++s) asm volatile("" :: "v"(qf[s]));
    f32x16 o1[4];
#pragma unroll
    for (int c = 0; c < 4; ++c) o1[c] = f32x16{};
    float m1 = -1e30f, l1 = 0.f;
    unsigned long long mw_next = 0ull;
    if constexpr (MODE == 1) { mw_next = A.MASK[qrow * 64]; asm volatile("" : "+v"(mw_next)); }
    bf16x8 pk[4]; float a1 = 1.f;
#define KFRAG(S_, K0_, K1_) do { if ((S_) < 8) { const unsigned ad_ = 256u * r32 + 16u * ((unsigned)(2 * (S_) + hi + 8 * strm) ^ fK); \
                K0_ = *(const LAS bf16x8*)(sb + ST_K + ad_); K1_ = *(const LAS bf16x8*)(sb + ST_K + ad_ + 8192); } \
            else { const unsigned ad_ = 128u * r32 + 16u * ((unsigned)(2 * ((S_) - 8) + hi) ^ g64); \
                K0_ = *(const LAS bf16x8*)(sb + ST_K64 + ad_); K1_ = *(const LAS bf16x8*)(sb + ST_K64 + ad_ + 4096); } } while (0)
#define QK_PASS(NS_) do { _Pragma("unroll") for (int b_ = 0; b_ < (NS_); b_ += 4) { bf16x8 ka[4], kb[4]; \
                _Pragma("unroll") for (int i_ = 0; i_ < 4; ++i_) KFRAG(b_ + i_, ka[i_], kb[i_]); \
                __builtin_amdgcn_sched_barrier(0); \
                _Pragma("unroll") for (int i_ = 0; i_ < 4; ++i_) { s0 = __builtin_amdgcn_mfma_f32_32x32x16_bf16(ka[i_], qf[b_ + i_], s0, 0, 0, 0); s1 = __builtin_amdgcn_mfma_f32_32x32x16_bf16(kb[i_], qf[b_ + i_], s1, 0, 0, 0); } \
                __builtin_amdgcn_sched_barrier(0); } } while (0)
#define VTR_ASM(DST_, ADDR_) asm volatile("ds_read_b64_tr_b16 %0, %1" : "=v"(DST_) : "v"(ADDR_))
#define PV_PASS(SB_) do { if (__any(a1 != 1.f)) { _Pragma("unroll") for (int c = 0; c < 4; ++c) o1[c] *= a1; } \
            const unsigned vb_ = (unsigned)(uintptr_t)(SB_) + ST_V + 8u * (p4 & 1); \
            _Pragma("unroll") for (int b_ = 0; b_ < 16; b_ += 8) { s16x4 vl[8], vh[8]; \
                _Pragma("unroll") for (int i_ = 0; i_ < 8; ++i_) { const int c_ = (b_ + i_) >> 2, ks_ = (b_ + i_) & 3; const unsigned chi_ = (unsigned)((c_ ^ q4) << 2); \
                    VTR_ASM(vl[i_], vb_ + 256u * (16 * ks_ + vrow[0]) + 16u * (chi_ | vlow[0])); \
                    VTR_ASM(vh[i_], vb_ + 256u * (16 * ks_ + vrow[1]) + 16u * (chi_ | vlow[1])); } \
                asm volatile("s_waitcnt lgkmcnt(0)" ::: "memory"); __builtin_amdgcn_sched_barrier(0); \
                _Pragma("unroll") for (int i_ = 0; i_ < 8; ++i_) { const s16x4 lo = vl[i_], h4 = vh[i_]; \
                    const bf16x8 vf = (bf16x8){lo[0], lo[1], lo[2], lo[3], h4[0], h4[1], h4[2], h4[3]}; \
                    o1[(b_ + i_) >> 2] = __builtin_amdgcn_mfma_f32_32x32x16_bf16(vf, pk[(b_ + i_) & 3], o1[(b_ + i_) >> 2], 0, 0, 0); } \
                __builtin_amdgcn_sched_barrier(0); } } while (0)
#define WAIT_TILE(all_) do { if (all_) asm volatile("s_waitcnt vmcnt(0) lgkmcnt(0)" ::: "memory"); \
        else if constexpr (MODE == 0) asm volatile("s_waitcnt vmcnt(5) lgkmcnt(0)" ::: "memory"); else asm volatile("s_waitcnt vmcnt(4) lgkmcnt(0)" ::: "memory"); \
        __builtin_amdgcn_s_barrier(); asm volatile("" ::: "memory"); } while (0)
    WAIT_TILE(true);
    int st_cur = 0, st_nn = 2;
    for (int t = 0; t < NT; ++t) {
        unsigned mlo = 0, mhi = 0;
        if constexpr (MODE == 1) { if (t <= cw) {
            const unsigned long long w = mw_next; mlo = (unsigned)w >> (4 * hi); mhi = (unsigned)(w >> 32) >> (4 * hi);
            asm volatile("" : "+v"(mlo), "+v"(mhi));
            if (t < cw) { const unsigned long long* mp_ = A.MASK + qrow * 64 + t + 1; asm volatile("global_load_dwordx2 %0, %1, off" : "+v"(mw_next) : "v"(mp_) : "memory"); } } }
        const bool more2 = (t + 2 < NT);
        if (more2) STAGE(t + 2, st_nn);
        if (t <= cw) {
            const lptr sb = (lptr)(lds + st_cur * ST_BYTES);
            f32x16 s0 = f32x16{}, s1 = f32x16{};
            QK_PASS(NQ);
            if constexpr (MODE == 1) softmax_tile<true>(s0, s1, m1, l1, a1, mlo, mhi, pk); else softmax_tile<false>(s0, s1, m1, l1, a1, 0, 0, pk);
            PV_PASS(sb);
        }
        WAIT_TILE(!more2);
        st_cur = (st_cur == 2) ? 0 : st_cur + 1; st_nn = (st_nn == 2) ? 0 : st_nn + 1;
    }
#undef WAIT_TILE
#undef PV_PASS
#undef QK_PASS
#undef VTR_ASM
#undef KFRAG
    l1 = sum_x32(l1); const float i1 = 1.0f / l1;
    float rstd = 1.f;
    if constexpr (MODE == 2) {
        LAS float* xb = (LAS float*)lds + (wid >> 1) * 4096 + lane;
        if (strm == 1) { const float i2 = A.lam * i1;
#pragma unroll
            for (int c = 0; c < 4; ++c)
#pragma unroll
                for (int r = 0; r < 16; ++r) xb[(c * 16 + r) * 64] = o1[c][r] * i2; }
        __syncthreads();
        if (strm == 0) { float ss = 0.f;
#pragma unroll
            for (int c = 0; c < 4; ++c)
#pragma unroll
                for (int r = 0; r < 16; ++r) { const float v = o1[c][r] * i1 - xb[(c * 16 + r) * 64]; o1[c][r] = v; ss += v * v; }
            ss = sum_x32(ss); rstd = __builtin_amdgcn_rsqf(ss * (1.0f / 128.0f) + 1e-6f) * A.c_out; }
        __syncthreads();
        if (strm == 1) return;
    }
    const bf16_t* grow = A.G + qrow * 2048; bf16_t* orow = A.Go + qrow * 2048;
#pragma unroll
    for (int c = 0; c < 4; ++c)
#pragma unroll
        for (int rr = 0; rr < 4; ++rr) {
            const int dv = 32 * c + 8 * rr + 4 * hi;
            const u32x2 g = *(const u32x2*)(grow + dv);
            float v[4];
#pragma unroll
            for (int e = 0; e < 4; ++e) v[e] = o1[c][4 * rr + e];
            if (MODE == 2) { const f32x4 sg = *(const f32x4*)(A.subg + dv);
#pragma unroll
                for (int e = 0; e < 4; ++e) v[e] *= rstd * sg[e]; }
            else {
#pragma unroll
                for (int e = 0; e < 4; ++e) v[e] *= i1; }
            u32x2 w; w.x = cvtpk(v[0] * bf_lo(g.x), v[1] * bf_hi(g.x)); w.y = cvtpk(v[2] * bf_lo(g.y), v[3] * bf_hi(g.y));
            *(u32x2*)(orow + dv) = w;
        }
}
#undef STAGE
#undef DMA16
}
namespace sel {
using att::bf16x8; using att::u32x4; using att::bf16_t; using att::f32x4;
constexpr int L_QI = 0, L_HIST = 16384, L_PART = 32768 + 64,     L_PREF = L_PART + 2048, L_KREM = L_PREF + 64, L_NEQ = L_KREM + 64, L_FLAG = L_NEQ + 64, L_W = L_FLAG + 64;
__device__ __forceinline__ unsigned fkey(float f) { const unsigned u = __float_as_uint(f); return (u & 0x80000000u) ? ~u : (u | 0x80000000u); }

__device__ __forceinline__ void scan_hist(LAS char* lds, int shiftbits) {
    LAS unsigned* hist = (LAS unsigned*)(lds + L_HIST); LAS unsigned* part = (LAS unsigned*)(lds + L_PART);
    LAS unsigned* pref = (LAS unsigned*)(lds + L_PREF); LAS unsigned* kremS = (LAS unsigned*)(lds + L_KREM); LAS unsigned* neqS = (LAS unsigned*)(lds + L_NEQ);
    const int tid = opaque_tid(), q = tid & 15, g = tid >> 4;
    unsigned hv[8]; unsigned s = 0;
#pragma unroll
    for (int j = 0; j < 8; ++j) { hv[j] = hist[(8 * g + j) * 16 + q]; s += hv[j]; }
    const unsigned krem = kremS[q];
    part[g * 16 + q] = s;
    __syncthreads();
    unsigned above = 0;
#pragma unroll
    for (int gg = 0; gg < 32; ++gg) { const unsigned pv = part[gg * 16 + q]; above += (gg > g) ? pv : 0u; }
    if (above < krem && krem <= above + s) {
        unsigned cum = above; int bsel = 8 * g; unsigned hsel = 0; bool done = false;
#pragma unroll
        for (int j = 7; j >= 0; --j) { if (!done) { if (cum + hv[j] >= krem) { bsel = 8 * g + j; hsel = hv[j]; done = true; } else cum += hv[j]; } }
        pref[q] = (pref[q] << shiftbits) | (unsigned)bsel; kremS[q] = krem - cum; neqS[q] = hsel;
    }
    __syncthreads();
}
#define SEL_HADD(idx_) __hip_atomic_fetch_add(&hist[(idx_)], 1u, __ATOMIC_RELAXED, __HIP_MEMORY_SCOPE_WORKGROUP)

__device__ __forceinline__ void sel_unit(LAS char* lds, int b, int u, const bf16_t* QI, const bf16_t* KIDX, const float* WIDX, unsigned long long* MASK) {
    const int tid = opaque_tid(), lane = tid & 63, q16 = lane & 15, kg = lane >> 4, wid = __builtin_amdgcn_readfirstlane(tid >> 6);
    const size_t rowbase = (size_t)b * SEQ; const int q0 = u * 16, c = q0 >> 6;
    const size_t gq = rowbase + q0 + q16;
    if (c <= 3) {
        unsigned ones = 0xffffffffu; asm volatile("" : "+v"(ones));
        for (int i = tid; i < 16 * (c + 1); i += 512) { unsigned* mp = (unsigned*)(MASK + (rowbase + q0 + (i & 15)) * 64 + (i >> 4)); mp[0] = ones; mp[1] = ones; }
        return;
    }
    LAS unsigned* hist = (LAS unsigned*)(lds + L_HIST);
    LAS unsigned* pref = (LAS unsigned*)(lds + L_PREF); LAS unsigned* kremS = (LAS unsigned*)(lds + L_KREM); LAS unsigned* neqS = (LAS unsigned*)(lds + L_NEQ);
#pragma unroll
    for (int i = 0; i < 2; ++i) { const int id = tid + 512 * i, row = id >> 6, ch = id & 63;
        *(LAS u32x4*)(lds + L_QI + row * 1024 + ((ch ^ (row & 15)) << 4)) = *(const u32x4*)(QI + (rowbase + q0 + row) * 512 + ch * 8); }
    for (int i = tid; i < 4096; i += 512) hist[i] = 0u;
    if (tid < 16) { pref[tid] = 0u; kremS[tid] = 256u; }
    if (tid < 128) ((LAS float*)(lds + L_W))[tid] = WIDX[(rowbase + q0 + (tid & 15)) * 8 + (tid >> 4)];
    const LAS float* wl = (const LAS float*)(lds + L_W) + q16;
    __syncthreads();
    const int nj = (c - wid + 8) >> 3;
    u32x4 sc[8][4];
#pragma unroll
    for (int j = 0; j < 8; ++j) {
        if (j < nj) {
            int t = wid + 8 * j; asm volatile("" : "+s"(t));
#pragma unroll
            for (int kh = 0; kh < 2; ++kh) {
            bf16x8 kf[2][2];
#pragma unroll
            for (int kb = 0; kb < 2; ++kb)
#pragma unroll
                for (int ks = 0; ks < 2; ++ks) kf[kb][ks] = *(const bf16x8*)(KIDX + (rowbase + 64 * t + 32 * kh + 16 * kb + q16) * 64 + 32 * ks + 8 * kg);
#pragma unroll
            for (int kb = 0; kb < 2; ++kb) {
                f32x4 s = (f32x4){0.f, 0.f, 0.f, 0.f};
#pragma unroll
                for (int hh = 0; hh < 8; ++hh) {
                    f32x4 a = (f32x4){0.f, 0.f, 0.f, 0.f};
#pragma unroll
                    for (int ks = 0; ks < 2; ++ks) {
                        const bf16x8 qv = *(const LAS bf16x8*)(lds + L_QI + q16 * 1024 + (((hh * 8 + 4 * ks + kg) ^ q16) << 4));
                        a = __builtin_amdgcn_mfma_f32_16x16x32_bf16(kf[kb][ks], qv, a, 0, 0, 0);
                    }
                    const float wh = wl[hh * 16];
#pragma unroll
                    for (int i = 0; i < 4; ++i) s[i] += wh * fmaxf(a[i], 0.f);
                }
                u32x4 kk; kk.x = fkey(s[0]); kk.y = fkey(s[1]); kk.z = fkey(s[2]); kk.w = fkey(s[3]);
                sc[j][2 * kh + kb] = kk;
#pragma unroll
                for (int i = 0; i < 4; ++i) SEL_HADD((kk[i] >> 24) * 16 + q16);
                __builtin_amdgcn_sched_barrier(0);
            }
            asm volatile("" ::: "memory");
            }
        }
    }
#define SEL_TILE(j_) (wid + 8 * (j_))
    __syncthreads();
    scan_hist(lds, 8);
#pragma unroll 1
    for (int pass = 1; pass < 4; ++pass) {
        const int shift = 24 - 8 * pass;
        { const int t_ = opaque_tid(); for (int i = t_; i < 4096; i += 512) hist[i] = 0u; }
        __syncthreads();
        const unsigned pf = pref[q16];
        unsigned zz = 0u; asm volatile("" : "+v"(zz));
#pragma unroll
        for (int j = 0; j < 8; ++j) if (j < nj) {
#pragma unroll
            for (int kb = 0; kb < 4; ++kb)
#pragma unroll
                for (int i = 0; i < 4; ++i) { const unsigned k = sc[j][kb][i] | zz; SEL_HADD((((k >> (shift + 8)) == pf) ? ((k >> shift) & 255u) * 16 : 4096u) + q16); __builtin_amdgcn_sched_barrier(0); }
        }
        __syncthreads();
        scan_hist(lds, 8);
    }
    const unsigned kstar = pref[q16]; unsigned vthr = 0u;
    {
        LAS unsigned* flag = (LAS unsigned*)(lds + L_FLAG);
        const int t3 = opaque_tid();
        if (t3 == 0) flag[0] = 0u;
        __syncthreads();
        if (t3 < 16 && neqS[t3] > kremS[t3]) flag[0] = 1u;
        __syncthreads();
        if (flag[0]) {
            if (t3 < 16) pref[t3] = 0u;
#pragma unroll 1
            for (int pass = 0; pass < 2; ++pass) {
                { const int t_ = opaque_tid(); for (int i = t_; i < 4096; i += 512) hist[i] = 0u; }
                __syncthreads();
                const unsigned pf = pref[q16];
                unsigned zz = 0u; asm volatile("" : "+v"(zz));
#pragma unroll
                for (int j = 0; j < 8; ++j) if (j < nj) {
#pragma unroll
                    for (int kb = 0; kb < 4; ++kb)
#pragma unroll
                        for (int i = 0; i < 4; ++i) { const unsigned k = sc[j][kb][i] | zz;
                            const unsigned v = (4095u - (unsigned)(64 * SEL_TILE(j) + 16 * kb + 4 * (int)(__builtin_amdgcn_mbcnt_hi(~0u, __builtin_amdgcn_mbcnt_lo(~0u, zz)) >> 4) + i)) | zz;
                            SEL_HADD(((k == kstar && (pass == 0 || (v >> 4) == pf)) ? (pass == 0 ? (v >> 4) : (v & 15u)) * 16 : 4096u) + q16); __builtin_amdgcn_sched_barrier(0); }
                }
                __syncthreads();
                scan_hist(lds, pass == 0 ? 8 : 4);
            }
            vthr = pref[q16];
        }
    }
    const int tid2 = opaque_tid(), kg2 = (tid2 & 63) >> 4; const size_t gq2 = rowbase + q0 + (tid2 & 15);
#pragma unroll
    for (int j = 0; j < 8; ++j) if (j < nj) {
        const int t = SEL_TILE(j);
        unsigned lo = 0u, hi = 0u;
#pragma unroll
        for (int kb = 0; kb < 4; ++kb)
#pragma unroll
            for (int i = 0; i < 4; ++i) { const unsigned k = sc[j][kb][i]; const unsigned kin = 16 * kb + 4 * kg2 + i;
                const unsigned v = 4095u - (unsigned)(64 * t + kin);
                const unsigned s = ((k > kstar) || (k == kstar && v >= vthr)) ? 1u : 0u;
                if (kb < 2) lo |= s << kin; else hi |= s << (kin - 32); __builtin_amdgcn_sched_barrier(0); }
        { auto r = __builtin_amdgcn_permlane32_swap(lo, lo, false, false); lo = r[0] | r[1]; r = __builtin_amdgcn_permlane16_swap(lo, lo, false, false); lo = r[0] | r[1];
          r = __builtin_amdgcn_permlane32_swap(hi, hi, false, false); hi = r[0] | r[1]; r = __builtin_amdgcn_permlane16_swap(hi, hi, false, false); hi = r[0] | r[1]; }
        if (kg2 == 0) MASK[gq2 * 64 + t] = ((unsigned long long)hi << 32) | lo;
    }
    __syncthreads();
}
#undef SEL_HADD
#undef SEL_TILE
}
typedef unsigned short bf16;
typedef unsigned v4u __attribute__((ext_vector_type(4)));
typedef float f32x4 __attribute__((ext_vector_type(4)));
__device__ __forceinline__ unsigned f2bf(float f) { unsigned u = __builtin_bit_cast(unsigned, f); return (u + 0x7fffu + ((u >> 16) & 1u)) >> 16; }
__device__ __forceinline__ unsigned pk2(float lo, float hi) { return f2bf(lo) | (f2bf(hi) << 16); }
__device__ __forceinline__ float wave_sum(float v) {
#pragma unroll
    for (int o = 1; o < 64; o <<= 1) v += __shfl_xor(v, o);
    return v;
}
__device__ __forceinline__ int pairperm(int d, int nrot) { return d < nrot ? ((d & 1) ? (nrot / 2 + (d >> 1)) : (d >> 1)) : d; }
__device__ __forceinline__ int colmap_in(int n) {
    if (n < 384) return n;
    if (n < 448) return 640 + pairperm(n - 384, 64);
    if (n < 512) return 3904 + pairperm(n - 448, 16);
    if (n < 768) return 384 + (n - 512);
    if (n < 2816) { const int j = n - 768; return j < 768 ? 704 + j : (j < 1408 ? 3976 + (j - 768) : 6536 + (j - 1408)); }
    if (n < 4096) { const int j = n - 2816, w = j / 640, r = j % 640; return (w ? 2112 : 1472) + (r & ~127) + pairperm(r & 127, 32); }
    if (n < 5376) { const int j = n - 4096; return j < 640 ? 2752 + j : 5896 + (j - 640); }
    if (n < 6656) { const int j = n - 5376, w = j / 640, r = j % 640; return (w ? 5256 : 4616) + (r & ~63) + pairperm(r & 63, 16); }
    if (n < 7168) { const int j = n - 6656; return 3392 + (j & ~63) + pairperm(j & 63, 16); }
    return -1;
}
__device__ __forceinline__ int colmap_uq(int n) { if (n >= NUQ) return -1; const int hd = n / 192, d = n % 192; return hd * 192 + (d < 128 ? d : 128 + pairperm(d - 128, 64)); }
template <int MAP>
__device__ __forceinline__ void transpose_item(const float* W, int K, int Nsrc, int Ndst, bf16* WT, const float* gain, LAS float* scr, int item, int lane) {
    const int nblk = Ndst / 32, kb = item / nblk, nb = item % nblk, k0 = 64 * kb, n0 = 32 * nb;
    const int nn = n0 + (lane & 31); const int sc = MAP == 0 ? nn : (MAP == 1 ? colmap_in(nn) : colmap_uq(nn));
    float wv_[32];
#pragma unroll
    for (int i = 0; i < 32; ++i) { const int kk = 2 * i + (lane >> 5); wv_[i] = (sc >= 0) ? W[(size_t)(k0 + kk) * Nsrc + sc] : 0.f; }
#pragma unroll
    for (int i = 0; i < 32; ++i) { const int kk = 2 * i + (lane >> 5); float v = wv_[i]; if (gain) v *= gain[k0 + kk]; scr[kk * 33 + (lane & 31)] = v; }
    asm volatile("s_waitcnt lgkmcnt(0)" ::: "memory");
    const int c = lane & 7;
#pragma unroll
    for (int j = 0; j < 4; ++j) { const int n = (lane >> 3) + 8 * j; const LAS float* s = scr + (8 * c) * 33 + n;
        v4u o; o.x = pk2(s[0 * 33], s[1 * 33]); o.y = pk2(s[2 * 33], s[3 * 33]); o.z = pk2(s[4 * 33], s[5 * 33]); o.w = pk2(s[6 * 33], s[7 * 33]);
        *(v4u*)(WT + (size_t)(n0 + n) * K + k0 + 8 * c) = o; }
    asm volatile("s_waitcnt lgkmcnt(0)" ::: "memory");
}

struct Args {
    const float *x, *p; const int* pos; const float *w_in, *w_uq, *w_ukv, *w_o, *norm_g, *q_norm_g, *kv_norm_g, *lam_q1, *lam_k1, *lam_q2, *lam_k2, *subln_g, *w_ple, *w_pg, *final_g;
    float* out; unsigned char* ws;
};

__device__ __forceinline__ int fetch_item(unsigned* ctr, LAS unsigned* slot_unused) {
    unsigned sa = (unsigned)LDS_MAIN; asm volatile("" : "+v"(sa));
    LAS unsigned* slot = (LAS unsigned*)(uintptr_t)sa;
    __syncthreads();
    if (opaque_tid() == 0) *slot = atomicAdd(ctr, 1u);
    __syncthreads();
    return __builtin_amdgcn_readfirstlane((int)*slot);
}

typedef const __attribute__((address_space(4))) Args* argp_t;
#define OPQ_WS() argp_t ap = (argp_t)__builtin_amdgcn_kernarg_segment_ptr(); asm volatile("" : "+s"(ap)); unsigned char* ws = ap->ws
#define ctrl ((unsigned*)(ws + WS_CTRL))
#define ssqh ((float*)(ws + WS_SSQH))
#define ssqq ((float*)(ws + WS_SSQQ))
#define ssqkv ((float*)(ws + WS_SSQKV))
#define TAB ((pg8::tab_t*)(ws + WS_TAB))
#define WIN ((bf16*)(ws + WS_WIN))
#define WUQ ((bf16*)(ws + WS_WUQ))
#define WUKV ((bf16*)(ws + WS_WUKV))
#define WO ((bf16*)(ws + WS_WO))
#define WPG ((bf16*)(ws + WS_WPG))
#define WPLE ((bf16*)(ws + WS_WPLE))
#define PB ((bf16*)(ws + WS_PB))
#define HB ((bf16*)(ws + WS_HB))
#define HB2 ((bf16*)(ws + WS_HB2))
#define PLEO ((bf16*)(ws + WS_PLEO))
#define CQ ((bf16*)(ws + WS_CQ))
#define CKV ((bf16*)(ws + WS_CKV))
#define KROPE ((bf16*)(ws + WS_KROPE))
#define KIDX ((bf16*)(ws + WS_KIDX))
#define GATE ((bf16*)(ws + WS_GATE))
#define QKB ((bf16*)(ws + WS_QKB))
#define VBC ((bf16*)(ws + WS_VBC))
#define QKC ((bf16*)(ws + WS_QKC))
#define QI ((bf16*)(ws + WS_QI))
#define WIDX ((float*)(ws + WS_WIDX))
#define QMLA ((bf16*)(ws + WS_QMLA))
#define KMLA ((bf16*)(ws + WS_KMLA))
#define VMLA ((bf16*)(ws + WS_VMLA))
#define MASK ((unsigned long long*)(ws + WS_MASK))
#define W8T ((bf16*)(ws + WS_W8T))
#define SCR ((float*)(ws + WS_SCR + (size_t)bx * SCR_PER_BLOCK))

template <int PH, int SUB = 15>
__device__ __forceinline__ void run_phase(const int L) {
    extern __shared__ __attribute__((aligned(16))) unsigned char lds_raw[];
    LAS unsigned char* lds = (LAS unsigned char*)lds_raw;
    LAS unsigned* slot = (LAS unsigned*)(lds + LDS_MAIN);
    const int G = gridDim.x, bx = blockIdx.x;
    if constexpr (PH == 0) {
    for (int rep0 = 0; rep0 < REP_P0; ++rep0)
    {
        OPQ_WS();
        const int tid = opaque_tid(), lane = tid & 63, wave = __builtin_amdgcn_readfirstlane(tid >> 6);
        const int gt = bx * 512 + tid, NGT = G * 512, gw = bx * 8 + wave, NGW = G * 8;
        for (int i = gt; i < CTRL_WORDS; i += NGT) ctrl[i] = 0u;
        LAS float* scr = (LAS float*)(lds + wave * 8704);
        constexpr int I_IN = (DM / 64) * (NIN / 32), I_UQ = (KUQ / 64) * (NUQP / 32), I_UKV = (KUKV / 64) * (NUKV / 32), I_SQ = (DM / 64) * (DM / 32), I_PLE = (PLE / 64) * (DM / 32);
        constexpr int I_L = I_IN + I_UQ + I_UKV + 2 * I_SQ + I_PLE;
        for (int it = gw; it < DEPTH * I_L; it += NGW) {
            const int L = it / I_L; int r = it % I_L;
            if (r < I_IN) { transpose_item<1>(ap->w_in + (size_t)L * DM * DIN, DM, DIN, NIN, WIN + (size_t)L * NIN * DM, ap->norm_g + L * DM, scr, r, lane); continue; } r -= I_IN;
            if (r < I_UQ) { transpose_item<2>(ap->w_uq + (size_t)L * KUQ * NUQ, KUQ, NUQ, NUQP, WUQ + (size_t)L * NUQP * KUQ, ap->q_norm_g + L * KUQ, scr, r, lane); continue; } r -= I_UQ;
            if (r < I_UKV) { transpose_item<0>(ap->w_ukv + (size_t)L * KUKV * NUKV, KUKV, NUKV, NUKV, WUKV + (size_t)L * NUKV * KUKV, ap->kv_norm_g + L * KUKV, scr, r, lane); continue; } r -= I_UKV;
            if (r < I_SQ) { transpose_item<0>(ap->w_o + (size_t)L * DM * DM, DM, DM, DM, WO + (size_t)L * DM * DM, nullptr, scr, r, lane); continue; } r -= I_SQ;
            if (r < I_SQ) { transpose_item<0>(ap->w_pg + (size_t)L * DM * DM, DM, DM, DM, WPG + (size_t)L * DM * DM, nullptr, scr, r, lane); continue; } r -= I_SQ;
            transpose_item<0>(ap->w_ple + (size_t)L * PLE * DM, PLE, DM, DM, WPLE + (size_t)L * DM * PLE, nullptr, scr, r, lane);
        }
        for (int i = gt; i < DEPTH * 16 * DM; i += NGT) { const int Lw = i / (16 * DM), c = (i / DM) & 15, k = i % DM;
            W8T[i] = (bf16)((c < 8) ? f2bf(ap->w_in[((size_t)Lw * DM + k) * DIN + 3968 + c] * ap->norm_g[Lw * DM + k]) : 0u); }
        { const int n8 = DEPTH * TOK * PLE / 8;
#pragma unroll 4
          for (int i = gt; i < n8; i += NGT) { const f32x4 v0 = *(const f32x4*)(ap->p + (size_t)i * 8), v1 = *(const f32x4*)(ap->p + (size_t)i * 8 + 4);
              v4u o; o.x = pk2(v0[0], v0[1]); o.y = pk2(v0[2], v0[3]); o.z = pk2(v1[0], v1[1]); o.w = pk2(v1[2], v1[3]); *(v4u*)(PB + (size_t)i * 8) = o; } }
        for (int m = gw; m < TOK; m += NGW) {
            const f32x4* xr = (const f32x4*)(ap->x + (size_t)m * DM) + lane; float s = 0.f;
            unsigned long long* o8 = (unsigned long long*)(HB + (size_t)m * DM) + lane;
#pragma unroll
            for (int j = 0; j < 8; ++j) { const f32x4 v = xr[64 * j]; s += (v[0] * v[0] + v[1] * v[1]) + (v[2] * v[2] + v[3] * v[3]);
                o8[64 * j] = (unsigned long long)pk2(v[0], v[1]) | ((unsigned long long)pk2(v[2], v[3]) << 32); }
            s = wave_sum(s); if (lane < 32) ssqh[(size_t)m * 32 + lane] = (lane == 0) ? s : 0.f;
        }
        for (int i = gt; i < TOK * NTAB; i += NGT) {
            const int t = i / NTAB, j = i % NTAB; int nrot, fi; if (j < 32) { nrot = 64; fi = j; } else if (j < 48) { nrot = 32; fi = j - 32; } else { nrot = 16; fi = j - 48; }
            const float e = (float)fi * (2.0f / (float)nrot); const float invf = 1.0f / powf(500000.0f, e);
            const float ang = (float)ap->pos[t] * invf; const double rev = (double)ang * 0.15915494309189535; const float fr = (float)(rev - floor(rev));
            TAB[i] = make_float2(__builtin_amdgcn_cosf(fr), __builtin_amdgcn_sinf(fr));
        }
    }

    }
    if constexpr (PH == 1) {
    for (int rep1 = 0; rep1 < REP_G1; ++rep1)
        {
            OPQ_WS();
            pg8::Gemm g{HB, WIN + (size_t)L * NIN * DM, TOK, NIN, DM}; pg8::StaticOrder S; S.init(TOK, NIN, G, bx);
            pg8::EpiIn E{ssqh, ssqq, ssqkv, CQ, CKV, KROPE, KIDX, GATE, QKB, VBC, QKC, QI, TAB};
#ifndef NO_G1
            pg8::gemm_phase<pg8::EpiIn, pg8::StaticOrder, true, true>(lds, g, S, E);
#endif
            pg8::Gemm g2{PB + (size_t)L * TOK * PLE, WPLE + (size_t)L * DM * PLE, TOK, DM, PLE}; pg8::StaticOrder S2; S2.init(TOK, DM, G, (bx + 64) % G);
            pg8::EpiPlain E2{PLEO, DM};
#ifndef NO_G1B
            pg8::gemm_phase<pg8::EpiPlain, pg8::StaticOrder, true, true>(lds, g2, S2, E2);
#endif
            {
                const int tid = opaque_tid(), lane = tid & 63, wave = __builtin_amdgcn_readfirstlane(tid >> 6);
                for (int grp = bx * 8 + wave; grp < TOK / 16; grp += G * 8) {
                    const bf16* pa = HB + (size_t)(grp * 16 + (lane & 15)) * DM + 8 * (lane >> 4);
                    const bf16* pb = W8T + ((size_t)L * 16 + (lane & 15)) * DM + 8 * (lane >> 4);
                    f32x4 acc = (f32x4){0.f, 0.f, 0.f, 0.f};
#pragma unroll 16
                    for (int s = 0; s < DM / 32; ++s) acc = __builtin_amdgcn_mfma_f32_16x16x32_bf16(*(const att::bf16x8*)(pa + 32 * s), *(const att::bf16x8*)(pb + 32 * s), acc, 0, 0, 0);
                    if ((lane & 15) < 8) {
#pragma unroll
                        for (int i = 0; i < 4; ++i) { const int row = grp * 16 + 4 * (lane >> 4) + i;
                            const float r = __builtin_amdgcn_rsqf(pg8::sum_parts<8>(ssqh + (size_t)row * 32) * (1.0f / 2048.0f) + 1e-6f);
                            WIDX[(size_t)row * 8 + (lane & 15)] = acc[i] * r; }
                    }
                }
            }
        }
    }
    if constexpr (PH == 2) {
        {
            OPQ_WS();
            if constexpr (SUB & 1) {
            { pg8::Gemm g{CQ, WUQ + (size_t)L * NUQP * KUQ, TOK, NUQP, KUQ}; pg8::StaticOrder S; S.init(TOK, NUQP, G, bx);
              pg8::EpiUq E{ssqq, QMLA};

#ifndef NO_G2
              pg8::gemm_phase<pg8::EpiUq, pg8::StaticOrder, true, false>(lds, g, S, E);
#endif
 }
            }
            if constexpr (SUB & 8) {
            { pg8::Gemm g{CKV, WUKV + (size_t)L * NUKV * KUKV, TOK, NUKV, KUKV}; pg8::StaticOrder S; S.init(TOK, NUKV, G, (bx + 64) % G);
              pg8::EpiUkv E{ssqkv, KMLA, VMLA};

#ifndef NO_G2B
              pg8::gemm_phase<pg8::EpiUkv, pg8::StaticOrder, true, true>(lds, g, S, E);
#endif
 }
            }
            if constexpr (SUB & 2) {
            float s1 = 0.f, s2 = 0.f;
            for (int i = 0; i < 64; ++i) { s1 += ap->lam_q1[L * 64 + i] * ap->lam_k1[L * 64 + i]; s2 += ap->lam_q2[L * 64 + i] * ap->lam_k2[L * 64 + i]; }
            const float lam_init = 0.8f - 0.6f * expf(-0.3f * (float)L); const float lam = expf(s1) - expf(s2) + lam_init;
            for (int rep = 0; rep < REP_A2; ++rep)
            { unsigned* ctr = ctrl + L * 32 + 0 + 4 * rep;
              for (;;) {
                const int it = fetch_item(ctr, slot);
                if (it >= 640) break;
                const int qb = 31 - it / 20, bh = it % 20, b = bh / 5, h = bh % 5;
                att::AttnPtrs A{QKC + 2 * h * 64, 1280, QKC + 640 + 2 * h * 64, 1280, nullptr, VBC + 640 + h * 128, 1280, GATE + 1408 + h * 128, GATE + 1408 + h * 128, nullptr, lam, 1.0f - lam_init, ap->subln_g + L * 128};
#ifndef NO_A2
                att::attn_unit<2>((LAS char*)lds, A, b, qb);
#endif
              } }
            }
            if constexpr (SUB & 4)
            for (int rep = 0; rep < REP_SEL; ++rep)
            { unsigned* ctr = ctrl + L * 32 + 1 + 4 * rep;
              for (;;) {
                const int j = fetch_item(ctr, slot);
                if (j >= 1024) break;
                const int u = 255 - j / 4, b = j % 4;
#ifndef NO_SEL
                sel::sel_unit((LAS char*)lds, b, u, QI, KIDX, WIDX, MASK);
#endif
              } }
        }
    }
    if constexpr (PH == 3) {
        {
            OPQ_WS();
            for (int rep = 0; rep < REP_A01; ++rep) {
            unsigned* ctr = ctrl + L * 32 + 2 + 4 * rep;
            for (;;) {
                const int it = fetch_item(ctr, slot);
                if (it >= 704) break;
                const int qb = 15 - it / 44, w = it % 44;
                if (w < 24) { const int b = w / 6, h = w % 6;
                    att::AttnPtrs A{QMLA + h * 192, NUQ, KMLA + h * 128, 768, KROPE, VMLA + h * 128, 768, GATE + h * 128, GATE + h * 128, nullptr, 0.f, 0.f, (const float*)TAB};
#ifndef NO_A0
                    att::attn_unit<0>((LAS char*)lds, A, b, qb);
#endif
                } else { const int w2 = w - 24, b = w2 / 5, h = w2 % 5;
                    att::AttnPtrs A{QKB + h * 128, 1280, QKB + 640 + h * 128, 1280, nullptr, VBC + h * 128, 1280, GATE + 768 + h * 128, GATE + 768 + h * 128, MASK, 0.f, 0.f, nullptr};
#ifndef NO_A1
                    att::attn_unit<1>((LAS char*)lds, A, b, qb);
#endif
                }
            }
            }
        }
    }
    if constexpr (PH == 4) {
        {
            OPQ_WS();
            pg8::Gemm g{GATE, WO + (size_t)L * DM * DM, TOK, DM, DM};     pg8::StaticOrder S; S.init(TOK, DM, G, bx);
            pg8::EpiWo E{HB, HB2};
#ifndef NO_G4
            pg8::gemm_phase<pg8::EpiWo, pg8::StaticOrder, true, true>(lds, g, S, E);
#endif
        }
    }
    if constexpr (PH == 5) {
        {
            OPQ_WS();
            pg8::Gemm g{HB2, WPG + (size_t)L * DM * DM, TOK, DM, DM}; pg8::StaticOrder S; S.init(TOK, DM, G, bx);
            pg8::EpiPg E{HB, PLEO, ssqh, HB2};
#ifndef NO_G5
            pg8::gemm_phase<pg8::EpiPg, pg8::StaticOrder, true, true>(lds, g, S, E);
#endif
        }
    }
    if constexpr (PH == 6) {
    {
        OPQ_WS();
        const int tid = opaque_tid();
        const int gt = bx * 512 + tid, NGT = G * 512; const float* ss = ssqh;
        for (int i = gt; i < TOK * DM / 4; i += NGT) { const int row = i / (DM / 4), c4 = i % (DM / 4);
            const float r = __builtin_amdgcn_rsqf(pg8::sum_parts<8>(ss + (size_t)row * 32) * (1.0f / 2048.0f) + 1e-6f); const f32x4 gv = *(const f32x4*)(ap->final_g + c4 * 4);
            const unsigned long long hw = *(const unsigned long long*)(HB + (size_t)i * 4); const unsigned w0 = (unsigned)hw, w1 = (unsigned)(hw >> 32);
            f32x4 v = (f32x4){__uint_as_float(w0 << 16), __uint_as_float(w0 & 0xffff0000u), __uint_as_float(w1 << 16), __uint_as_float(w1 & 0xffff0000u)}; v = v * r * gv; *(f32x4*)(ap->out + (size_t)i * 4) = v; }
    }
    }
}
__device__ __forceinline__ void init_wave_table() {
    extern __shared__ __attribute__((aligned(16))) unsigned char lds_raw[];
    const unsigned hw = __builtin_amdgcn_s_getreg((5 << 11) | 4) & 63u;
    if ((threadIdx.x & 63) == 0) { *(volatile LAS int*)(uintptr_t)(LDS_WTAB + hw * 4) = (int)(threadIdx.x >> 6); if (threadIdx.x == 0x7fffffff) lds_raw[0] = 0; }
    if (threadIdx.x == 0) { *(volatile LAS unsigned*)(uintptr_t)(LDS_MAIN + 16) = 0u; *(volatile LAS unsigned*)(uintptr_t)(LDS_MAIN + 20) = 0u; }
    __syncthreads();
}
#define RLX_AGENT __ATOMIC_RELAXED, __HIP_MEMORY_SCOPE_AGENT
#define XB_TMO      128
#define XB_XCNT(j)  (256  + 64 * (j))
#define XB_XSUB(j)  (1280 + 64 * (j))
#define XB_XGEN(j)  (2304 + 64 * (j))
#define XB_TOP      3328
#define XB_TOPGEN   3392
#define XCD_BAR_WORDS 3456
#define XB_SPIN_CAP (1u << 18)

__device__ __forceinline__ unsigned xb_ld(unsigned* p)              { return __hip_atomic_load(p, __ATOMIC_RELAXED, __HIP_MEMORY_SCOPE_AGENT); }
__device__ __forceinline__ unsigned xb_add(unsigned* p, unsigned v) { return __hip_atomic_fetch_add(p, v, __ATOMIC_RELAXED, __HIP_MEMORY_SCOPE_AGENT); }
__device__ __forceinline__ unsigned xb_xcc_id() { return (unsigned)__builtin_amdgcn_s_getreg((3 << 11) | 20) & 0xFu; }
#define XB_SPIN(cond, bar) do { unsigned _sp = 0; while (cond) { __builtin_amdgcn_s_sleep(1); \
    if ((++_sp & 255u) == 0u) { if (xb_ld(&(bar)[XB_TMO])) break; if (_sp > XB_SPIN_CAP) { atomicAdd(&(bar)[XB_TMO], 1u); break; } } } } while (0)

struct XcdBarrier {
    unsigned* bar; unsigned x;
    volatile LAS unsigned* st;
};

__device__ __forceinline__ XcdBarrier xcd_barrier_post(unsigned* bar, volatile LAS unsigned* st) {
    XcdBarrier b; b.bar = bar; b.x = xb_xcc_id(); b.st = st;
    if (opaque_tid() == 0) (void)xb_add(&bar[XB_XCNT(b.x)], 1u);
    return b;
}
__device__ __forceinline__ void xcd_barrier_complete(unsigned* bar, unsigned x, unsigned& nloc, unsigned& nx) {
    const unsigned G = gridDim.x * gridDim.y * gridDim.z;
    unsigned sum, cnt, mine, sp = 0u;
    for (;;) {
        sum = 0u; cnt = 0u; mine = 0u;
#pragma unroll
        for (unsigned j = 0; j < 16; ++j) { const unsigned c = xb_ld(&bar[XB_XCNT(j)]); sum += c; cnt += (c > 0u) ? 1u : 0u; mine = (j == x) ? c : mine; }
        if (sum == G) break;
        __builtin_amdgcn_s_sleep(1);
        if ((++sp & 255u) == 0u) { if (xb_ld(&bar[XB_TMO])) break; if (sp > XB_SPIN_CAP) { atomicAdd(&bar[XB_TMO], 1u); break; } }
    }
    nloc = mine > 0u ? mine : 1u; nx = cnt > 0u ? cnt : 1u;
}

__device__ __forceinline__ void xcd_barrier(const XcdBarrier& b) {
    asm volatile("s_waitcnt vmcnt(0)" ::: "memory");
    __syncthreads();
    if (opaque_tid() == 0) {
        unsigned* bar = b.bar;
        __builtin_amdgcn_s_waitcnt(0);
        unsigned nloc = b.st[0], nx = b.st[1];
        if (nloc == 0u) { xcd_barrier_complete(bar, b.x, nloc, nx); b.st[0] = nloc; b.st[1] = nx; }
        const unsigned old = xb_add(&bar[XB_XSUB(b.x)], 1u);
        const unsigned gen = old / nloc;
        if (old + 1u == (gen + 1u) * nloc) {
            __builtin_amdgcn_fence(__ATOMIC_RELEASE, "agent");
            asm volatile("s_waitcnt vmcnt(0)" ::: "memory");
            const unsigned og = xb_add(&bar[XB_TOP], 1u);
            const unsigned tg = og / nx;
            if (og + 1u == (tg + 1u) * nx) xb_add(&bar[XB_TOPGEN], 1u);
            else XB_SPIN(xb_ld(&bar[XB_TOPGEN]) == tg, bar);
            __builtin_amdgcn_fence(__ATOMIC_ACQUIRE, "agent");
            xb_add(&bar[XB_XGEN(b.x)], 1u);
            asm volatile("s_waitcnt vmcnt(0)" ::: "memory");
        } else {
            XB_SPIN(xb_ld(&bar[XB_XGEN(b.x)]) == gen, bar);
            __builtin_amdgcn_fence(__ATOMIC_ACQUIRE, "agent");
            asm volatile("s_waitcnt vmcnt(0)" ::: "memory");
        }
    }
    __syncthreads();
}

#ifdef MULTI_LAUNCH
template <int PH, int SUB> __global__ void __launch_bounds__(512, 2) k_phase(Args a_kernarg, int L) { init_wave_table(); run_phase<PH, SUB>(L); }
#else
__global__ void __launch_bounds__(512, 2) hybrid_fwd(Args a_kernarg) {
    cg::grid_group grid = cg::this_grid();
    init_wave_table();
    run_phase<0>(0);
    grid.sync();
#define XBAR_MAKE() argp_t apb = (argp_t)__builtin_amdgcn_kernarg_segment_ptr(); asm volatile("" : "+s"(apb)); unsigned* barw = (unsigned*)(apb->ws + WS_CTRL) + CW_BAR
    { XBAR_MAKE(); (void)xcd_barrier_post(barw, (volatile LAS unsigned*)(uintptr_t)(LDS_MAIN + 16)); }
#define GSYNC() do { XBAR_MAKE(); XcdBarrier xb_; xb_.bar = barw; xb_.x = xb_xcc_id(); xb_.st = (volatile LAS unsigned*)(uintptr_t)(LDS_MAIN + 16); for (int rs_ = 0; rs_ < REP_SYNC; ++rs_) xcd_barrier(xb_); } while (0)
    for (int L = 0; L < DEPTH; ++L) {
        run_phase<1>(L); GSYNC();
        run_phase<2>(L); GSYNC();
        run_phase<3>(L); GSYNC();
        run_phase<4>(L); GSYNC();
        run_phase<5>(L); GSYNC();
    }
    run_phase<6>(0);
}
#endif

extern "C" void kernel_launch(void* const* d_in, const int* in_sizes, int n_in, void* d_out, int out_size, void* d_ws, size_t ws_size, hipStream_t stream) {
    static int grid = 0;
    if (grid == 0) {
        if (n_in != 18 || out_size != TOK * DM || ws_size < WS_END) { fprintf(stderr, "kernel_launch: unexpected shapes (n_in %d out %d ws %zu need %zu)\n", n_in, out_size, ws_size, (size_t)WS_END); grid = -1; return; }
        int dev = 0, cus = 0;
        (void)hipGetDevice(&dev); (void)hipDeviceGetAttribute(&cus, hipDeviceAttributeMultiprocessorCount, dev);
#ifdef MULTI_LAUNCH
        (void)hipFuncSetAttribute((const void*)k_phase<0, 7>, hipFuncAttributeMaxDynamicSharedMemorySize, LDS_BYTES);
        (void)hipFuncSetAttribute((const void*)k_phase<1, 7>, hipFuncAttributeMaxDynamicSharedMemorySize, LDS_BYTES);
        (void)hipFuncSetAttribute((const void*)k_phase<2, 1>, hipFuncAttributeMaxDynamicSharedMemorySize, LDS_BYTES);
        (void)hipFuncSetAttribute((const void*)k_phase<2, 8>, hipFuncAttributeMaxDynamicSharedMemorySize, LDS_BYTES);
        (void)hipFuncSetAttribute((const void*)k_phase<2, 2>, hipFuncAttributeMaxDynamicSharedMemorySize, LDS_BYTES);
        (void)hipFuncSetAttribute((const void*)k_phase<2, 4>, hipFuncAttributeMaxDynamicSharedMemorySize, LDS_BYTES);
        (void)hipFuncSetAttribute((const void*)k_phase<3, 7>, hipFuncAttributeMaxDynamicSharedMemorySize, LDS_BYTES);
        (void)hipFuncSetAttribute((const void*)k_phase<4, 7>, hipFuncAttributeMaxDynamicSharedMemorySize, LDS_BYTES);
        (void)hipFuncSetAttribute((const void*)k_phase<5, 7>, hipFuncAttributeMaxDynamicSharedMemorySize, LDS_BYTES);
        (void)hipFuncSetAttribute((const void*)k_phase<6, 7>, hipFuncAttributeMaxDynamicSharedMemorySize, LDS_BYTES);
#else
        int per_cu = 0;
        (void)hipFuncSetAttribute((const void*)hybrid_fwd, hipFuncAttributeMaxDynamicSharedMemorySize, LDS_BYTES);
        (void)hipOccupancyMaxActiveBlocksPerMultiprocessor(&per_cu, (const void*)hybrid_fwd, 512, LDS_BYTES);
        if (per_cu < 1) fprintf(stderr, "kernel_launch: occupancy query says %d blocks per CU\n", per_cu);
#endif
        (void)hipGetLastError();
        grid = cus > 256 ? 256 : cus;
    }
    if (grid < 0) return;
    Args a{};
    a.x = (const float*)d_in[0]; a.p = (const float*)d_in[1]; a.pos = (const int*)d_in[2]; a.w_in = (const float*)d_in[3]; a.w_uq = (const float*)d_in[4]; a.w_ukv = (const float*)d_in[5];
    a.w_o = (const float*)d_in[6]; a.norm_g = (const float*)d_in[7]; a.q_norm_g = (const float*)d_in[8]; a.kv_norm_g = (const float*)d_in[9]; a.lam_q1 = (const float*)d_in[10]; a.lam_k1 = (const float*)d_in[11];
    a.lam_q2 = (const float*)d_in[12]; a.lam_k2 = (const float*)d_in[13]; a.subln_g = (const float*)d_in[14]; a.w_ple = (const float*)d_in[15]; a.w_pg = (const float*)d_in[16]; a.final_g = (const float*)d_in[17];
    a.out = (float*)d_out; a.ws = (unsigned char*)d_ws;
#ifdef MULTI_LAUNCH
    k_phase<0, 7><<<grid, 512, LDS_BYTES, stream>>>(a, 0);
    for (int L = 0; L < DEPTH; ++L) {
        k_phase<1, 7><<<grid, 512, LDS_BYTES, stream>>>(a, L); k_phase<2, 1><<<grid, 512, LDS_BYTES, stream>>>(a, L); k_phase<2, 8><<<grid, 512, LDS_BYTES, stream>>>(a, L); k_phase<2, 2><<<grid, 512, LDS_BYTES, stream>>>(a, L); k_phase<2, 4><<<grid, 512, LDS_BYTES, stream>>>(a, L); k_phase<3, 7><<<grid, 512, LDS_BYTES, stream>>>(a, L);
        k_phase<4, 7><<<grid, 512, LDS_BYTES, stream>>>(a, L); k_phase<5, 7><<<grid, 512, LDS_BYTES, stream>>>(a, L);
    }
    k_phase<6, 7><<<grid, 512, LDS_BYTES, stream>>>(a, 0);
#else
    void* args[] = {&a};
    hipError_t e = hipLaunchCooperativeKernel((const void*)hybrid_fwd, dim3(grid), dim3(512), args, LDS_BYTES, stream);
    if (e != hipSuccess) fprintf(stderr, "cooperative launch failed: %s (grid %d)\n", hipGetErrorString(e), grid);
#endif
}
```
